# Optimizing an MI355X kernel written in HIP

```python
import math
import jax, jax.numpy as jnp
from jax import lax
import numpy as np

D_MODEL = 1024
BATCH = 32
SEQ = 2048
DEPTH = 1

N_DIFF_HEADS = 4
DIFF_HEAD_DIM = 64
DIFF_V_DIM = 2 * DIFF_HEAD_DIM
DIFF_WIDTH = N_DIFF_HEADS * DIFF_V_DIM
N_MLSTM_HEADS = 4
MLSTM_QK_DIM = 64
MLSTM_V_DIM = 128
MLSTM_WIDTH = N_MLSTM_HEADS * MLSTM_V_DIM
MIX_WIDTH = DIFF_WIDTH + MLSTM_WIDTH
CONV_WIDTH = 4
CHUNK = 64
Q_BLOCK = 128
D_FF = 4 * D_MODEL
ROPE_THETA = 10000.0
EPS = 1e-6

IN_SIZES = (
    N_DIFF_HEADS * 2 * DIFF_HEAD_DIM,
    N_DIFF_HEADS * 2 * DIFF_HEAD_DIM,
    DIFF_WIDTH,
    N_MLSTM_HEADS * MLSTM_QK_DIM,
    N_MLSTM_HEADS * MLSTM_QK_DIM,
    MLSTM_WIDTH,
    MLSTM_WIDTH,
    N_MLSTM_HEADS,
    N_MLSTM_HEADS,
)
IN_WIDTH = sum(IN_SIZES)
IN_OFFSETS = tuple(int(o) for o in np.cumsum(IN_SIZES)[:-1])
CONV_CH = 2 * N_MLSTM_HEADS * MLSTM_QK_DIM

kernel_name = "hybrid_diffattn_mlstm_parallel_heads"


def lambda_init(layer):
    return 0.8 - 0.6 * math.exp(-0.3 * layer)


def rmsnorm(x, g):
    xf = x.astype(jnp.float32)
    y = xf * lax.rsqrt(jnp.mean(xf * xf, axis=-1, keepdims=True) + EPS)
    return (y * g.astype(jnp.float32)).astype(x.dtype)


def rope(x, pos):
    d = x.shape[-1]
    inv = ROPE_THETA ** (-jnp.arange(0, d, 2, dtype=jnp.float32) / d)
    ang = pos.astype(jnp.float32)[:, None] * inv[None, :]
    cos = jnp.cos(ang)[None, :, None, :]
    sin = jnp.sin(ang)[None, :, None, :]
    xf = x.astype(jnp.float32)
    x1, x2 = xf[..., : d // 2], xf[..., d // 2:]
    out = jnp.concatenate([x1 * cos - x2 * sin, x2 * cos + x1 * sin], axis=-1)
    return out.astype(x.dtype)


def diff_attention(q, k, v, lam):
    S = q.shape[3]
    scale = DIFF_HEAD_DIM ** -0.5
    outs = []
    for blk in range(S // Q_BLOCK):
        lo, hi = blk * Q_BLOCK, (blk + 1) * Q_BLOCK
        qb = q[:, :, :, lo:hi]
        kb = k[:, :, :, :hi]
        s = jnp.einsum('bhcqd,bhckd->bhcqk', qb, kb).astype(jnp.float32) * scale
        mask = (lo + jnp.arange(Q_BLOCK))[:, None] >= jnp.arange(hi)[None, :]
        s = jnp.where(mask, s, -jnp.inf)
        p = jax.nn.softmax(s, axis=-1)
        p_diff = p[:, :, 0] - lam * p[:, :, 1]
        outs.append(jnp.einsum('bhqk,bhkv->bhqv', p_diff.astype(v.dtype), v[:, :, :hi]))
    return jnp.concatenate(outs, axis=2)


def mlstm_chunkwise(q, k, v, i_pre, logf):
    B, H, S, dqk = q.shape
    dv = v.shape[-1]
    nc = S // CHUNK
    q = q * (dqk ** -0.5)

    def chunked(t):
        t = t.reshape(t.shape[:2] + (nc, CHUNK) + t.shape[3:])
        return jnp.moveaxis(t, 2, 0)

    xs = (chunked(q), chunked(k), chunked(v), chunked(i_pre), chunked(logf))
    causal = jnp.tril(jnp.ones((CHUNK, CHUNK), dtype=bool))

    def step(carry, inp):
        C, n, m = carry
        qc, kc, vc, ic, fc = inp
        b = jnp.cumsum(fc, axis=-1)
        g = b[..., -1]
        logD = b[..., :, None] - b[..., None, :] + ic[..., None, :]
        logD = jnp.where(causal, logD, -jnp.inf)
        inter = b + m[..., None]
        m_comb = jnp.maximum(inter, jnp.max(logD, axis=-1))
        scores = jnp.einsum('bhjd,bhsd->bhjs', qc, kc) * jnp.exp(logD - m_comb[..., None])
        w_inter = jnp.exp(inter - m_comb)
        num = (w_inter[..., None] * jnp.einsum('bhjd,bhdv->bhjv', qc, C)
               + jnp.einsum('bhjs,bhsv->bhjv', scores, vc))
        den = w_inter * jnp.einsum('bhjd,bhd->bhj', qc, n) + jnp.sum(scores, axis=-1)
        h = num / jnp.maximum(jnp.abs(den), jnp.exp(-m_comb))[..., None]
        log_w = g[..., None] - b + ic
        m_new = jnp.maximum(g + m, jnp.max(log_w, axis=-1))
        decay = jnp.exp(g + m - m_new)
        w = jnp.exp(log_w - m_new[..., None])
        C_new = decay[..., None, None] * C + jnp.einsum('bhs,bhsd,bhsv->bhdv', w, kc, vc)
        n_new = decay[..., None] * n + jnp.einsum('bhs,bhsd->bhd', w, kc)
        return (C_new, n_new, m_new), h

    init = (jnp.zeros((B, H, dqk, dv), jnp.float32),
            jnp.zeros((B, H, dqk), jnp.float32),
            jnp.zeros((B, H), jnp.float32))
    _, hs = lax.scan(step, init, xs)
    return jnp.moveaxis(hs, 0, 2).reshape(B, H, S, dv)


def causal_dwconv(x, w, b):
    S = x.shape[1]
    xp = jnp.pad(x, ((0, 0), (CONV_WIDTH - 1, 0), (0, 0)))
    y = b
    for j in range(CONV_WIDTH):
        y = y + w[j] * xp[:, j:j + S]
    return y


def setup_inputs(seed: int = 0) -> dict:
    key = jax.random.key(seed)
    ks = jax.random.split(key, 20)
    f32 = jnp.float32
    nrm = lambda k, shape, s: jax.random.normal(k, shape, f32) * s
    gain = lambda k, shape: 1.0 + 0.05 * jax.random.normal(k, shape, f32)
    return {
        "x": jax.random.normal(ks[0], (BATCH, SEQ, D_MODEL), f32),
        "norm_mix_pre": gain(ks[1], (DEPTH, D_MODEL)),
        "w_in": nrm(ks[2], (DEPTH, D_MODEL, IN_WIDTH), D_MODEL ** -0.5),
        "conv_w": nrm(ks[3], (DEPTH, CONV_WIDTH, CONV_CH), CONV_WIDTH ** -0.5),
        "conv_b": nrm(ks[4], (DEPTH, CONV_CH), 0.01),
        "b_igate": nrm(ks[5], (DEPTH, N_MLSTM_HEADS), 0.1),
        "b_fgate": 3.0 + nrm(ks[6], (DEPTH, N_MLSTM_HEADS), 0.5),
        "lambda_q1": nrm(ks[7], (DEPTH, DIFF_HEAD_DIM), 0.1),
        "lambda_k1": nrm(ks[8], (DEPTH, DIFF_HEAD_DIM), 0.1),
        "lambda_q2": nrm(ks[9], (DEPTH, DIFF_HEAD_DIM), 0.1),
        "lambda_k2": nrm(ks[10], (DEPTH, DIFF_HEAD_DIM), 0.1),
        "diff_norm": gain(ks[11], (DEPTH, DIFF_V_DIM)),
        "mlstm_norm": gain(ks[12], (DEPTH, N_MLSTM_HEADS, MLSTM_V_DIM)),
        "w_out": nrm(ks[13], (DEPTH, MIX_WIDTH, D_MODEL), MIX_WIDTH ** -0.5),
        "norm_mix_post": gain(ks[14], (DEPTH, D_MODEL)),
        "norm_mlp_pre": gain(ks[15], (DEPTH, D_MODEL)),
        "w_up": nrm(ks[16], (DEPTH, D_MODEL, D_FF), D_MODEL ** -0.5),
        "w_down": nrm(ks[17], (DEPTH, D_FF, D_MODEL), D_FF ** -0.5),
        "norm_mlp_post": gain(ks[18], (DEPTH, D_MODEL)),
    }


def reference(x, norm_mix_pre, w_in, conv_w, conv_b, b_igate, b_fgate,
              lambda_q1, lambda_k1, lambda_q2, lambda_k2, diff_norm, mlstm_norm,
              w_out, norm_mix_post, norm_mlp_pre, w_up, w_down, norm_mlp_post):
    B, S, _ = x.shape
    pos = jnp.arange(S, dtype=jnp.int32)
    for l in range(DEPTH):
        lam_init = lambda_init(l)
        h = rmsnorm(x, norm_mix_pre[l])
        proj = h @ w_in[l]
        dq, dk, dvv, mq, mk, mv, mo, mi, mf = jnp.split(proj, IN_OFFSETS, axis=-1)

        dq = rope(dq.reshape(B, S, 2 * N_DIFF_HEADS, DIFF_HEAD_DIM), pos)
        dk = rope(dk.reshape(B, S, 2 * N_DIFF_HEADS, DIFF_HEAD_DIM), pos)
        dq = dq.reshape(B, S, N_DIFF_HEADS, 2, DIFF_HEAD_DIM).transpose(0, 2, 3, 1, 4)
        dk = dk.reshape(B, S, N_DIFF_HEADS, 2, DIFF_HEAD_DIM).transpose(0, 2, 3, 1, 4)
        dvv = dvv.reshape(B, S, N_DIFF_HEADS, DIFF_V_DIM).transpose(0, 2, 1, 3)
        lam = (jnp.exp(jnp.sum(lambda_q1[l].astype(jnp.float32) * lambda_k1[l].astype(jnp.float32)))
               - jnp.exp(jnp.sum(lambda_q2[l].astype(jnp.float32) * lambda_k2[l].astype(jnp.float32)))
               + lam_init)
        o_diff = diff_attention(dq, dk, dvv, lam)
        o_diff = rmsnorm(o_diff, diff_norm[l]) * (1.0 - lam_init)
        o_diff = o_diff.transpose(0, 2, 1, 3).reshape(B, S, DIFF_WIDTH)

        qk = causal_dwconv(jnp.concatenate([mq, mk], axis=-1), conv_w[l], conv_b[l])
        qk = jax.nn.silu(qk)
        mq, mk = qk[..., :CONV_CH // 2], qk[..., CONV_CH // 2:]
        to_heads = lambda t, d: t.reshape(B, S, N_MLSTM_HEADS, d).transpose(0, 2, 1, 3).astype(jnp.float32)
        i_pre = (mi + b_igate[l]).astype(jnp.float32).transpose(0, 2, 1)
        logf = jax.nn.log_sigmoid((mf + b_fgate[l]).astype(jnp.float32)).transpose(0, 2, 1)
        hm = mlstm_chunkwise(to_heads(mq, MLSTM_QK_DIM), to_heads(mk, MLSTM_QK_DIM),
                             to_heads(mv, MLSTM_V_DIM), i_pre, logf)
        hm = rmsnorm(hm.transpose(0, 2, 1, 3), mlstm_norm[l]).astype(x.dtype)
        o_mlstm = hm.reshape(B, S, MLSTM_WIDTH) * jax.nn.sigmoid(mo)

        mixed = jnp.concatenate([o_diff.astype(x.dtype), o_mlstm], axis=-1) @ w_out[l]
        x = x + rmsnorm(mixed, norm_mix_post[l])

        h = rmsnorm(x, norm_mlp_pre[l])
        u = jnp.square(jax.nn.relu(h @ w_up[l]))
        x = x + rmsnorm(u @ w_down[l], norm_mlp_post[l])
    return x
```

```cpp
#include <hip/hip_runtime.h>
#include <cstdint>
#include <cstdio>

typedef unsigned short bf16_t;
typedef short bf16x8 __attribute__((ext_vector_type(8)));
typedef float f32x4 __attribute__((ext_vector_type(4)));
typedef float f32x16 __attribute__((ext_vector_type(16)));

constexpr int NB = 32, SEQ = 2048, DM = 1024, M = NB * SEQ, NPROJ = 3072, INW = 3080, FF = 4096;
constexpr float EPS = 1e-6f;
constexpr float LAM_INIT = 0.2f;
constexpr float QSCALE = 0.125f * 1.4426950408889634f;

constexpr size_t MiB = 1u << 20;
constexpr size_t WS_CTL = 0, WS_ROPE = 1 * MiB, WS_WG = 1 * MiB + 512 * 1024, WS_GATES = 2 * MiB;
constexpr size_t WS_W1 = 4 * MiB, WS_W2 = 10 * MiB, WS_W3 = 12 * MiB, WS_W4 = 20 * MiB;
constexpr size_t WS_XN = 32 * MiB;
constexpr size_t WS_Q = 160 * MiB, WS_K = 224 * MiB, WS_V = 288 * MiB, WS_MQ = 352 * MiB, WS_MK = 384 * MiB, WS_MV = 416 * MiB, WS_MO = 480 * MiB;
constexpr size_t WS_MIX = 544 * MiB, WS_X1N = 672 * MiB, WS_U = 32 * MiB, WS_END = 800 * MiB;
constexpr size_t WS_T1 = 160 * MiB, WS_T2 = 544 * MiB;

__device__ __forceinline__ unsigned f2bf(float f) { unsigned u = __float_as_uint(f); return (u + 0x7fffu + ((u >> 16) & 1u)) >> 16; }
__device__ __forceinline__ float bf2f(unsigned h) { return __uint_as_float(h << 16); }
__device__ __forceinline__ float wave_sum(float v) {
#pragma unroll
    for (int o = 1; o < 64; o <<= 1) v += __shfl_xor(v, o);
    return v;
}

__global__ void __launch_bounds__(256) k_prep_w(const float* __restrict__ W, int K, int N, int ldW, const float* __restrict__ g, bf16_t* __restrict__ out) {
    __shared__ float tile[32][33];
    const int n0 = blockIdx.x * 32, k0 = blockIdx.y * 32, tx = threadIdx.x & 31, ty = threadIdx.x >> 5;
#pragma unroll
    for (int i = 0; i < 4; ++i) { const int k = k0 + ty + 8 * i; tile[ty + 8 * i][tx] = W[(size_t)k * ldW + n0 + tx] * (g ? g[k] : 1.f); }
    __syncthreads();
#pragma unroll
    for (int i = 0; i < 4; ++i) { const int n = n0 + ty + 8 * i; out[(size_t)n * K + k0 + tx] = (bf16_t)f2bf(tile[tx][ty + 8 * i]); }
}
__global__ void __launch_bounds__(256) k_prep_misc(const float* __restrict__ w_in, const float* __restrict__ g, float* __restrict__ WG, float2* __restrict__ rope) {
    const int i = blockIdx.x * 256 + threadIdx.x;
    if (i < 8 * 1024) { const int j = i >> 10, k = i & 1023; WG[i] = g[k] * w_in[(size_t)k * INW + NPROJ + j]; }
    if (i < SEQ * 32) {
        const int pos = i >> 5, j = i & 31;
        const float inv = (float)pow(10000.0, -(double)(2 * j) / 64.0);
        const float ang = (float)pos * inv;
        rope[i] = make_float2((float)cos((double)ang), (float)sin((double)ang));
    }
}
__global__ void __launch_bounds__(256) k_rows0(const float* __restrict__ x, const float* __restrict__ WG, const float* __restrict__ b_i, const float* __restrict__ b_f,
                                               bf16_t* __restrict__ XN, float* __restrict__ GATES) {
    const int lane = threadIdx.x & 63, row = blockIdx.x * 4 + (threadIdx.x >> 6);
    const f32x4* xr = (const f32x4*)(x + (size_t)row * DM) + lane;
    f32x4 v[4]; float ss = 0.f;
#pragma unroll
    for (int j = 0; j < 4; ++j) { v[j] = xr[64 * j]; ss += (v[j].x * v[j].x + v[j].y * v[j].y) + (v[j].z * v[j].z + v[j].w * v[j].w); }
    const float rstd = 1.0f / sqrtf(wave_sum(ss) * (1.f / DM) + EPS);
    unsigned long long* o8 = (unsigned long long*)(XN + (size_t)row * DM) + lane;
#pragma unroll
    for (int j = 0; j < 4; ++j) o8[64 * j] = (unsigned long long)(f2bf(v[j].x * rstd) | (f2bf(v[j].y * rstd) << 16)) | ((unsigned long long)(f2bf(v[j].z * rstd) | (f2bf(v[j].w * rstd) << 16)) << 32);
    float gsum[8];
#pragma unroll
    for (int q = 0; q < 8; ++q) {
        const f32x4* wr = (const f32x4*)(WG + q * 1024) + lane; float a = 0.f;
#pragma unroll
        for (int j = 0; j < 4; ++j) { const f32x4 w = wr[64 * j]; a += (v[j].x * w.x + v[j].y * w.y) + (v[j].z * w.z + v[j].w * w.w); }
        gsum[q] = wave_sum(a) * rstd;
    }
    if (lane < 4) GATES[(size_t)row * 8 + lane] = (lane == 0 ? gsum[0] : lane == 1 ? gsum[1] : lane == 2 ? gsum[2] : gsum[3]) + b_i[lane];
    else if (lane < 8) {
        const int h = lane - 4; const float z = (h == 0 ? gsum[4] : h == 1 ? gsum[5] : h == 2 ? gsum[6] : gsum[7]) + b_f[h];
        GATES[(size_t)row * 8 + lane] = fminf(z, 0.f) - log1pf(expf(-fabsf(z)));
    }
}

struct GemmOut { bf16_t *Q, *K, *V, *MQ, *MK, *MV, *MO; const float2* rope; float* F; bf16_t* U; };
template <int MODE>
__global__ void __launch_bounds__(256) k_gemm(const bf16_t* __restrict__ A, const bf16_t* __restrict__ Bt, int Kd, GemmOut o) {
    const int lane = threadIdx.x & 63, wid = threadIdx.x >> 6, r32 = lane & 31, hi = lane >> 5;
    const int m0 = blockIdx.y * 128 + (wid >> 1) * 64, n0 = blockIdx.x * 128 + (wid & 1) * 64;
    f32x16 acc[2][2];
#pragma unroll
    for (int i = 0; i < 2; ++i)
#pragma unroll
        for (int j = 0; j < 2; ++j) acc[i][j] = f32x16{};
    const bf16_t* a0 = A + (size_t)(m0 + r32) * Kd + hi * 8;
    const bf16_t* b0 = Bt + (size_t)(n0 + r32) * Kd + hi * 8;
    for (int k = 0; k < Kd; k += 16) {
        bf16x8 af[2], bf[2];
#pragma unroll
        for (int i = 0; i < 2; ++i) { af[i] = *(const bf16x8*)(a0 + (size_t)i * 32 * Kd + k); bf[i] = *(const bf16x8*)(b0 + (size_t)i * 32 * Kd + k); }
#pragma unroll
        for (int i = 0; i < 2; ++i)
#pragma unroll
            for (int j = 0; j < 2; ++j) acc[i][j] = __builtin_amdgcn_mfma_f32_32x32x16_bf16(af[i], bf[j], acc[i][j], 0, 0, 0);
    }
    if (MODE == 1) {
        if (n0 < 1024) {
            bf16_t* dst = (n0 < 512) ? o.Q : o.K; const int c0 = n0 & 511; const float sc = (n0 < 512) ? QSCALE : 1.f;
#pragma unroll
            for (int i = 0; i < 2; ++i)
#pragma unroll
                for (int r = 0; r < 16; ++r) {
                    const int row = m0 + 32 * i + (r & 3) + 8 * (r >> 2) + 4 * hi; const float2 cs = o.rope[(row & (SEQ - 1)) * 32 + r32];
                    const float x1 = acc[i][0][r], x2 = acc[i][1][r];
                    dst[(size_t)row * 512 + c0 + r32] = (bf16_t)f2bf((x1 * cs.x - x2 * cs.y) * sc);
                    dst[(size_t)row * 512 + c0 + 32 + r32] = (bf16_t)f2bf((x2 * cs.x + x1 * cs.y) * sc);
                }
        } else {
            bf16_t* dst; int ld, c0;
            if (n0 < 1536) { dst = o.V; ld = 512; c0 = n0 - 1024; } else if (n0 < 1792) { dst = o.MQ; ld = 256; c0 = n0 - 1536; } else if (n0 < 2048) { dst = o.MK; ld = 256; c0 = n0 - 1792; }
            else if (n0 < 2560) { dst = o.MV; ld = 512; c0 = n0 - 2048; } else { dst = o.MO; ld = 512; c0 = n0 - 2560; }
#pragma unroll
            for (int i = 0; i < 2; ++i)
#pragma unroll
                for (int j = 0; j < 2; ++j)
#pragma unroll
                    for (int r = 0; r < 16; ++r) { const int row = m0 + 32 * i + (r & 3) + 8 * (r >> 2) + 4 * hi; dst[(size_t)row * ld + c0 + 32 * j + r32] = (bf16_t)f2bf(acc[i][j][r]); }
        }
    } else {
#pragma unroll
        for (int i = 0; i < 2; ++i)
#pragma unroll
            for (int j = 0; j < 2; ++j)
#pragma unroll
                for (int r = 0; r < 16; ++r) {
                    const int row = m0 + 32 * i + (r & 3) + 8 * (r >> 2) + 4 * hi, col = n0 + 32 * j + r32; const float v = acc[i][j][r];
                    if (MODE == 2) o.F[(size_t)row * DM + col] = v; else { const float t = fmaxf(v, 0.f); o.U[(size_t)row * FF + col] = (bf16_t)f2bf(t * t); }
                }
    }
}

__global__ void __launch_bounds__(256) k_attn_naive(const bf16_t* __restrict__ Q, const bf16_t* __restrict__ K, const bf16_t* __restrict__ V, float* __restrict__ OC) {
    const int qb = blockIdx.x & 15, c = (blockIdx.x >> 4) & 1, h = (blockIdx.x >> 5) & 3, b = blockIdx.x >> 7;
    const int ql = threadIdx.x & 127, vh = threadIdx.x >> 7, q = qb * 128 + ql;
    const size_t rowq = (size_t)b * SEQ + q;
    float qf[64];
#pragma unroll
    for (int d = 0; d < 64; d += 2) { const unsigned w = *(const unsigned*)(Q + rowq * 512 + h * 128 + c * 64 + d); qf[d] = bf2f(w & 0xffffu); qf[d + 1] = bf2f(w >> 16); }
    float o[64];
#pragma unroll
    for (int v = 0; v < 64; ++v) o[v] = 0.f;
    float m = -INFINITY, l = 0.f;
    const int kend = qb * 128 + 127;
    for (int kk = 0; kk <= kend; ++kk) {
        const bf16_t* kp = K + ((size_t)b * SEQ + kk) * 512 + h * 128 + c * 64;
        const bf16_t* vp = V + ((size_t)b * SEQ + kk) * 512 + h * 128 + vh * 64;
        float s = 0.f;
#pragma unroll
        for (int d = 0; d < 64; d += 2) { const unsigned w = *(const unsigned*)(kp + d); s += qf[d] * bf2f(w & 0xffffu) + qf[d + 1] * bf2f(w >> 16); }
        if (kk <= q) {
            if (s > m) { const float a = exp2f(m - s); l *= a;
#pragma unroll
                for (int v = 0; v < 64; ++v) o[v] *= a;
                m = s; }
            const float p = exp2f(s - m); l += p;
#pragma unroll
            for (int v = 0; v < 64; v += 2) { const unsigned w = *(const unsigned*)(vp + v); o[v] += p * bf2f(w & 0xffffu); o[v + 1] += p * bf2f(w >> 16); }
        }
    }
    const float il = 1.f / l; float* op = OC + rowq * 1024 + h * 256 + c * 128 + vh * 64;
#pragma unroll
    for (int v = 0; v < 64; ++v) op[v] = o[v] * il;
}
__global__ void __launch_bounds__(256) k_attn_combine(const float* __restrict__ OC, const float* __restrict__ lq1, const float* __restrict__ lk1, const float* __restrict__ lq2, const float* __restrict__ lk2,
                                                      const float* __restrict__ dnorm, bf16_t* __restrict__ MIX) {
    const int lane = threadIdx.x & 63, w = blockIdx.x * 4 + (threadIdx.x >> 6), row = w >> 2, h = w & 3;
    const float lam = expf(wave_sum(lq1[lane] * lk1[lane])) - expf(wave_sum(lq2[lane] * lk2[lane])) + LAM_INIT;
    const float* p = OC + (size_t)row * 1024 + h * 256;
    const float a0 = p[lane] - lam * p[128 + lane], a1 = p[64 + lane] - lam * p[192 + lane];
    const float rstd = 1.0f / sqrtf(wave_sum(a0 * a0 + a1 * a1) * (1.f / 128.f) + EPS);
    MIX[(size_t)row * 1024 + h * 128 + lane] = (bf16_t)f2bf(a0 * rstd * dnorm[lane] * (1.f - LAM_INIT));
    MIX[(size_t)row * 1024 + h * 128 + 64 + lane] = (bf16_t)f2bf(a1 * rstd * dnorm[64 + lane] * (1.f - LAM_INIT));
}

__global__ void __launch_bounds__(256) k_mlstm_naive(const bf16_t* __restrict__ MQ, const bf16_t* __restrict__ MK, const bf16_t* __restrict__ MV, const bf16_t* __restrict__ MO, const float* __restrict__ GATES,
                                                     const float* __restrict__ conv_w, const float* __restrict__ conv_b, const float* __restrict__ mnorm, bf16_t* __restrict__ MIX) {
    extern __shared__ __attribute__((aligned(16))) float sm[];
    float* Cs = sm;
    float* vs = Cs + 64 * 128;
    float* hs = vs + 64 * 128;
    float* qs = hs + 64 * 128;
    float* ks = qs + 64 * 65;
    float* sc = ks + 64 * 65;
    float* ns = sc + 64 * 65;
    float* bb = ns + 64; float* ii = bb + 64; float* lf = ii + 64; float* mcomb = lf + 64; float* winter = mcomb + 64; float* denom = winter + 64; float* wv = denom + 64; float* rs = wv + 64;
    float* scal = rs + 64;
    const int tid = threadIdx.x, b = blockIdx.x >> 2, h = blockIdx.x & 3;
    for (int e = tid; e < 64 * 128; e += 256) Cs[e] = 0.f;
    if (tid < 64) ns[tid] = 0.f;
    if (tid == 0) scal[0] = 0.f;
    __syncthreads();
    for (int c = 0; c < SEQ / 64; ++c) {
        const size_t row0 = (size_t)b * SEQ + c * 64;
        for (int e = tid; e < 64 * 64; e += 256) {
            const int t = e >> 6, d = e & 63; float aq = conv_b[h * 64 + d], ak = conv_b[256 + h * 64 + d];
#pragma unroll
            for (int j = 0; j < 4; ++j) { const int tt = c * 64 + t - 3 + j;
                if (tt >= 0) { aq += conv_w[j * 512 + h * 64 + d] * bf2f(MQ[((size_t)b * SEQ + tt) * 256 + h * 64 + d]); ak += conv_w[j * 512 + 256 + h * 64 + d] * bf2f(MK[((size_t)b * SEQ + tt) * 256 + h * 64 + d]); } }
            qs[t * 65 + d] = aq / (1.f + expf(-aq)) * 0.125f; ks[t * 65 + d] = ak / (1.f + expf(-ak));
        }
        for (int e = tid; e < 64 * 128; e += 256) { const int t = e >> 7, v = e & 127; vs[e] = bf2f(MV[(row0 + t) * 512 + h * 128 + v]); }
        if (tid < 64) { ii[tid] = GATES[(row0 + tid) * 8 + h]; lf[tid] = GATES[(row0 + tid) * 8 + 4 + h]; }
        __syncthreads();
        if (tid < 64) { float a = 0.f; for (int s = 0; s <= tid; ++s) a += lf[s]; bb[tid] = a; }
        __syncthreads();
        const float m = scal[0], g = bb[63];
        if (tid < 64) { const int j = tid; const float inter = bb[j] + m; float mx = inter; for (int s = 0; s <= j; ++s) mx = fmaxf(mx, bb[j] - bb[s] + ii[s]); mcomb[j] = mx; winter[j] = expf(inter - mx); }
        __syncthreads();
        for (int e = tid; e < 64 * 64; e += 256) {
            const int j = e >> 6, s = e & 63; float v = 0.f;
            if (s <= j) { float dot = 0.f; for (int d = 0; d < 64; ++d) dot += qs[j * 65 + d] * ks[s * 65 + d]; v = dot * expf(bb[j] - bb[s] + ii[s] - mcomb[j]); }
            sc[j * 65 + s] = v;
        }
        __syncthreads();
        if (tid < 64) { const int j = tid; float qn = 0.f, ssum = 0.f; for (int d = 0; d < 64; ++d) qn += qs[j * 65 + d] * ns[d]; for (int s = 0; s < 64; ++s) ssum += sc[j * 65 + s];
            const float den = winter[j] * qn + ssum; denom[j] = fmaxf(fabsf(den), expf(-mcomb[j])); }
        for (int e = tid; e < 64 * 128; e += 256) {
            const int j = e >> 7, v = e & 127; float a = 0.f, bsum = 0.f;
            for (int d = 0; d < 64; ++d) a += qs[j * 65 + d] * Cs[d * 128 + v];
            for (int s = 0; s < 64; ++s) bsum += sc[j * 65 + s] * vs[s * 128 + v];
            hs[e] = winter[j] * a + bsum;
        }
        __syncthreads();
        for (int e = tid; e < 64 * 128; e += 256) hs[e] = hs[e] / denom[e >> 7];
        __syncthreads();
        if (tid < 64) { float ss = 0.f; for (int v = 0; v < 128; ++v) { const float t = hs[tid * 128 + v]; ss += t * t; } rs[tid] = 1.0f / sqrtf(ss * (1.f / 128.f) + EPS); }
        if (tid >= 64 && tid < 128) { const int s = tid - 64; wv[s] = g - bb[s] + ii[s]; }
        __syncthreads();
        for (int e = tid; e < 64 * 128; e += 256) {
            const int j = e >> 7, v = e & 127; const float og = bf2f(MO[(row0 + j) * 512 + h * 128 + v]);
            MIX[(row0 + j) * 1024 + 512 + h * 128 + v] = (bf16_t)f2bf(hs[e] * rs[j] * mnorm[h * 128 + v] / (1.f + expf(-og)));
        }
        if (tid == 0) { float mx = g + m; for (int s = 0; s < 64; ++s) mx = fmaxf(mx, wv[s]); scal[2] = mx; scal[1] = expf(g + m - mx); }
        __syncthreads();
        const float mnew = scal[2], decay = scal[1];
        if (tid < 64) wv[tid] = expf(wv[tid] - mnew);
        __syncthreads();
        for (int e = tid; e < 64 * 128; e += 256) { const int d = e >> 7, v = e & 127; float a = 0.f; for (int s = 0; s < 64; ++s) a += wv[s] * ks[s * 65 + d] * vs[s * 128 + v]; Cs[e] = decay * Cs[e] + a; }
        if (tid < 64) { const int d = tid; float a = 0.f; for (int s = 0; s < 64; ++s) a += wv[s] * ks[s * 65 + d]; ns[d] = decay * ns[d] + a; }
        if (tid == 0) scal[0] = mnew;
        __syncthreads();
    }
}
constexpr int MLSTM_LDS = (3 * 64 * 128 + 3 * 64 * 65 + 64 * 9 + 16) * 4;

__global__ void __launch_bounds__(256) k_rownorm1(const float* __restrict__ x, const float* __restrict__ T1, const float* __restrict__ gpost, float* __restrict__ X1, bf16_t* __restrict__ X1N) {
    const int lane = threadIdx.x & 63, row = blockIdx.x * 4 + (threadIdx.x >> 6);
    const f32x4* tr = (const f32x4*)(T1 + (size_t)row * DM) + lane; const f32x4* xr = (const f32x4*)(x + (size_t)row * DM) + lane; const f32x4* gr = (const f32x4*)gpost + lane;
    f32x4 t[4]; float ss = 0.f;
#pragma unroll
    for (int j = 0; j < 4; ++j) { t[j] = tr[64 * j]; ss += (t[j].x * t[j].x + t[j].y * t[j].y) + (t[j].z * t[j].z + t[j].w * t[j].w); }
    const float rstd = 1.0f / sqrtf(wave_sum(ss) * (1.f / DM) + EPS); float s2 = 0.f;
#pragma unroll
    for (int j = 0; j < 4; ++j) { t[j] = xr[64 * j] + t[j] * rstd * gr[64 * j]; s2 += (t[j].x * t[j].x + t[j].y * t[j].y) + (t[j].z * t[j].z + t[j].w * t[j].w); }
    const float rstd2 = 1.0f / sqrtf(wave_sum(s2) * (1.f / DM) + EPS);
    f32x4* o = (f32x4*)(X1 + (size_t)row * DM) + lane; unsigned long long* o8 = (unsigned long long*)(X1N + (size_t)row * DM) + lane;
#pragma unroll
    for (int j = 0; j < 4; ++j) { o[64 * j] = t[j];
        o8[64 * j] = (unsigned long long)(f2bf(t[j].x * rstd2) | (f2bf(t[j].y * rstd2) << 16)) | ((unsigned long long)(f2bf(t[j].z * rstd2) | (f2bf(t[j].w * rstd2) << 16)) << 32); }
}
__global__ void __launch_bounds__(256) k_rownorm2(const float* __restrict__ T2, const float* __restrict__ g, float* __restrict__ out) {
    const int lane = threadIdx.x & 63, row = blockIdx.x * 4 + (threadIdx.x >> 6);
    const f32x4* tr = (const f32x4*)(T2 + (size_t)row * DM) + lane; const f32x4* gr = (const f32x4*)g + lane; f32x4* o = (f32x4*)(out + (size_t)row * DM) + lane;
    f32x4 t[4]; float ss = 0.f;
#pragma unroll
    for (int j = 0; j < 4; ++j) { t[j] = tr[64 * j]; ss += (t[j].x * t[j].x + t[j].y * t[j].y) + (t[j].z * t[j].z + t[j].w * t[j].w); }
    const float rstd = 1.0f / sqrtf(wave_sum(ss) * (1.f / DM) + EPS);
#pragma unroll
    for (int j = 0; j < 4; ++j) o[64 * j] = o[64 * j] + t[j] * rstd * gr[64 * j];
}

extern "C" void kernel_launch(void* const* d_in, const int* in_sizes, int n_in, void* d_out, int out_size, void* d_ws, size_t ws_size, hipStream_t stream) {
    if (n_in != 19 || in_sizes[0] != M * DM || out_size != M * DM || ws_size < WS_END) { fprintf(stderr, "kernel_launch: unexpected problem shape (n_in %d, ws %zu)\n", n_in, ws_size); return; }
    const float* x = (const float*)d_in[0]; const float* g_pre = (const float*)d_in[1]; const float* w_in = (const float*)d_in[2]; const float* conv_w = (const float*)d_in[3]; const float* conv_b = (const float*)d_in[4];
    const float* b_i = (const float*)d_in[5]; const float* b_f = (const float*)d_in[6]; const float* lq1 = (const float*)d_in[7]; const float* lk1 = (const float*)d_in[8]; const float* lq2 = (const float*)d_in[9]; const float* lk2 = (const float*)d_in[10];
    const float* dnorm = (const float*)d_in[11]; const float* mnorm = (const float*)d_in[12]; const float* w_out = (const float*)d_in[13]; const float* g_post = (const float*)d_in[14]; const float* g_pre2 = (const float*)d_in[15];
    const float* w_up = (const float*)d_in[16]; const float* w_down = (const float*)d_in[17]; const float* g_post2 = (const float*)d_in[18];
    unsigned char* ws = (unsigned char*)d_ws; float* out = (float*)d_out;
    bf16_t *W1 = (bf16_t*)(ws + WS_W1), *W2 = (bf16_t*)(ws + WS_W2), *W3 = (bf16_t*)(ws + WS_W3), *W4 = (bf16_t*)(ws + WS_W4), *XN = (bf16_t*)(ws + WS_XN);
    bf16_t *Q = (bf16_t*)(ws + WS_Q), *K = (bf16_t*)(ws + WS_K), *V = (bf16_t*)(ws + WS_V), *MQ = (bf16_t*)(ws + WS_MQ), *MK = (bf16_t*)(ws + WS_MK), *MV = (bf16_t*)(ws + WS_MV), *MO = (bf16_t*)(ws + WS_MO);
    bf16_t *MIX = (bf16_t*)(ws + WS_MIX), *X1N = (bf16_t*)(ws + WS_X1N), *U = (bf16_t*)(ws + WS_U);
    float *WG = (float*)(ws + WS_WG), *GATES = (float*)(ws + WS_GATES), *T1 = (float*)(ws + WS_T1), *T2 = (float*)(ws + WS_T2); float2* rope = (float2*)(ws + WS_ROPE);
    static bool attr_set = false;
    if (!attr_set) { hipFuncSetAttribute((const void*)k_mlstm_naive, hipFuncAttributeMaxDynamicSharedMemorySize, MLSTM_LDS); attr_set = true; }
    k_prep_w<<<dim3(NPROJ / 32, DM / 32), 256, 0, stream>>>(w_in, DM, NPROJ, INW, g_pre, W1);
    k_prep_w<<<dim3(DM / 32, DM / 32), 256, 0, stream>>>(w_out, DM, DM, DM, nullptr, W2);
    k_prep_w<<<dim3(FF / 32, DM / 32), 256, 0, stream>>>(w_up, DM, FF, FF, g_pre2, W3);
    k_prep_w<<<dim3(DM / 32, FF / 32), 256, 0, stream>>>(w_down, FF, DM, DM, nullptr, W4);
    k_prep_misc<<<SEQ * 32 / 256, 256, 0, stream>>>(w_in, g_pre, WG, rope);
    k_rows0<<<M / 4, 256, 0, stream>>>(x, WG, b_i, b_f, XN, GATES);
    GemmOut go{}; go.Q = Q; go.K = K; go.V = V; go.MQ = MQ; go.MK = MK; go.MV = MV; go.MO = MO; go.rope = rope;
    k_gemm<1><<<dim3(NPROJ / 128, M / 128), 256, 0, stream>>>(XN, W1, DM, go);
    k_attn_naive<<<NB * 4 * 2 * 16, 256, 0, stream>>>(Q, K, V, out);
    k_attn_combine<<<M * 4 / 4, 256, 0, stream>>>(out, lq1, lk1, lq2, lk2, dnorm, MIX);
    k_mlstm_naive<<<NB * 4, 256, MLSTM_LDS, stream>>>(MQ, MK, MV, MO, GATES, conv_w, conv_b, mnorm, MIX);
    GemmOut g2{}; g2.F = T1;
    k_gemm<2><<<dim3(DM / 128, M / 128), 256, 0, stream>>>(MIX, W2, DM, g2);
    k_rownorm1<<<M / 4, 256, 0, stream>>>(x, T1, g_post, out, X1N);
    GemmOut g3{}; g3.U = U;
    k_gemm<3><<<dim3(FF / 128, M / 128), 256, 0, stream>>>(X1N, W3, DM, g3);
    GemmOut g4{}; g4.F = T2;
    k_gemm<2><<<dim3(DM / 128, M / 128), 256, 0, stream>>>(U, W4, FF, g4);
    k_rownorm2<<<M / 4, 256, 0, stream>>>(T2, g_post2, out);
}
```

```cpp
#include <hip/hip_runtime.h>
#include <hip/hip_cooperative_groups.h>
#include <cstdint>
#include <cstdio>
namespace cg = cooperative_groups;

typedef unsigned short bf16_t;
typedef float f32x16 __attribute__((ext_vector_type(16)));

constexpr int NB = 32, SEQ = 2048, DM = 1024, M = NB * SEQ, NPROJ = 3072, INW = 3080, FF = 4096;
constexpr float EPS = 1e-6f;
constexpr float LAM_INIT = 0.2f;
constexpr float QSCALE = 0.125f * 1.4426950408889634f;

constexpr size_t MiB = 1u << 20;
constexpr size_t WS_CTL = 0, CTL_ZERO_BYTES = 1 * MiB, WS_ROPE = 1 * MiB, WS_WG = 1 * MiB + 512 * 1024, WS_GATES = 2 * MiB;
constexpr size_t WS_W1 = 4 * MiB, WS_W2 = 10 * MiB, WS_W3 = 12 * MiB, WS_W4 = 20 * MiB;
constexpr size_t WS_XN = 32 * MiB;
constexpr size_t WS_Q = 160 * MiB, WS_K = 224 * MiB, WS_V = 288 * MiB, WS_MQ = 352 * MiB, WS_MK = 384 * MiB, WS_MV = 416 * MiB, WS_MO = 480 * MiB;
constexpr size_t WS_MIX = 544 * MiB, WS_X1N = 672 * MiB, WS_U = 32 * MiB, WS_END = 800 * MiB;
constexpr size_t WS_T1 = 160 * MiB, WS_T2 = 544 * MiB;


__device__ __forceinline__ float bf2f(unsigned h) { return __uint_as_float(h << 16); }

__device__ __forceinline__ float wave_sum(float v) {
#pragma unroll
    for (int o = 1; o < 64; o <<= 1) v += __shfl_xor(v, o);
    return v;
}
namespace pg8 {
#define PG8_LAS __attribute__((address_space(3)))
typedef unsigned short bf16_t;
typedef short bf16x8 __attribute__((ext_vector_type(8)));
typedef float f32x4 __attribute__((ext_vector_type(4)));
typedef unsigned u32x4 __attribute__((ext_vector_type(4)));
constexpr int BM = 256, BK = 64, HALF = 128, HTB = HALF * BK * 2  , STAGE_BYTES = 8 * HTB, NXCD = 8, WGM = 8;

__host__ __device__ __forceinline__ int lds_byte(int r, int c) { const int st = (r >> 4) * 2 + (c >> 5), rr = r & 15, cc = c & 31, ob = rr * 64 + cc * 2; return st * 1024 + (ob ^ (((ob >> 9) & 1) << 5)); }
__host__ __device__ __forceinline__ void stage_rc(int b, int& R, int& C) { const int st = b / 1024, sb = b % 1024, swz = sb ^ (((sb >> 9) & 1) << 5); R = (st >> 1) * 16 + swz / 64; C = (st & 1) * 32 + (swz % 64) / 2; }
__host__ __device__ __forceinline__ int perm32(int rho) { const int n = rho >> 4, i = rho & 15; return 8 * (i >> 2) + 4 * n + (i & 3); }

struct Unit { int pm, pn; };
struct Gemm { const bf16_t* A; const bf16_t* Bt; int M, N, K; };

struct StaticOrder {
    int nM, nN, nwg, G, c;
    __host__ __device__ void init(int M, int N, int G_, int c_) { nM = M / BM; nN = N / BM; nwg = nM * nN; G = G_; c = c_; }
    __host__ __device__ bool next(int i, Unit& u) const {
        const long L = (long)i * G + c; if (L >= nwg) return false;
        int wgid = (int)L; { const int q = nwg / NXCD, r = nwg % NXCD, xcd = wgid % NXCD, off = wgid / NXCD; wgid = (xcd < r ? xcd * (q + 1) : r * (q + 1) + (xcd - r) * q) + off; }
        const int nig = WGM * nN, gid = wgid / nig, fm = gid * WGM, gsz = (nM - fm) < WGM ? (nM - fm) : WGM;
        u.pm = fm + ((wgid % nig) % gsz); u.pn = (wgid % nig) / gsz; return true;
    }
    __device__ __forceinline__ void a_ready(const Unit&) const {}
    __device__ __forceinline__ void done(const Unit&) const {}
};

__device__ __forceinline__ unsigned cvt_pk_bf16(float lo, float hi) { unsigned r; asm volatile("v_cvt_pk_bf16_f32 %0, %1, %2" : "=v"(r) : "v"(lo), "v"(hi)); return r; }
typedef unsigned u32x2 __attribute__((ext_vector_type(2)));

struct EpiProj {
    static constexpr bool AFTER_DRAIN = false;
    __host__ __device__ static int bperm(int R) { return 64 * (R >> 6) + 32 * ((R >> 4) & 1) + 16 * ((R >> 5) & 1) + (R & 15); }
    bf16_t *Q, *K, *V, *MQ, *MK, *MV, *MO; const float* rope;
    __device__ __forceinline__ void operator()(const f32x4 (&acc)[2][2][4][2], const Unit& u, int wr, int wc, int fr, int fq) const {
        const int row0 = u.pm * BM + wr * 64 + fr, cw = 64 * (wc >> 1) + 16 * (wc & 1) + 4 * fq, pn = u.pn;
        if (pn < 4) {
            bf16_t* dst = pn < 2 ? Q : K; const int c0 = (pn & 1) * 256 + cw; const float sc = pn < 2 ? QSCALE : 1.f;
#pragma unroll
            for (int ai = 0; ai < 2; ++ai)
#pragma unroll
                for (int m = 0; m < 4; ++m) {
                    const int row = row0 + ai * HALF + m * 16; const float* rp = rope + ((row & (SEQ - 1)) * 32 + 16 * (wc & 1) + 4 * fq) * 2;
                    const f32x4 t0 = *(const f32x4*)rp, t1 = *(const f32x4*)(rp + 4);
                    const f32x4 cs = (f32x4){t0[0], t0[2], t1[0], t1[2]} * sc, sn = (f32x4){t0[1], t0[3], t1[1], t1[3]} * sc;
                    bf16_t* rowp = dst + (size_t)row * 512 + c0;
#pragma unroll
                    for (int bj = 0; bj < 2; ++bj) { const f32x4 x1 = acc[ai][bj][m][0], x2 = acc[ai][bj][m][1]; const f32x4 o1 = x1 * cs - x2 * sn, o2 = x2 * cs + x1 * sn;
                        u32x2 w1, w2; w1.x = cvt_pk_bf16(o1[0], o1[1]); w1.y = cvt_pk_bf16(o1[2], o1[3]); w2.x = cvt_pk_bf16(o2[0], o2[1]); w2.y = cvt_pk_bf16(o2[2], o2[3]);
                        *(u32x2*)(rowp + bj * HALF) = w1; *(u32x2*)(rowp + bj * HALF + 32) = w2; }
                }
        } else {
            bf16_t* dst; int ld, c0;
            if (pn < 6) { dst = V; ld = 512; c0 = (pn - 4) * 256; } else if (pn == 6) { dst = MQ; ld = 256; c0 = 0; } else if (pn == 7) { dst = MK; ld = 256; c0 = 0; }
            else if (pn < 10) { dst = MV; ld = 512; c0 = (pn - 8) * 256; } else { dst = MO; ld = 512; c0 = (pn - 10) * 256; }
#pragma unroll
            for (int ai = 0; ai < 2; ++ai)
#pragma unroll
                for (int m = 0; m < 4; ++m) { bf16_t* rowp = dst + (size_t)(row0 + ai * HALF + m * 16) * ld + c0 + cw;
#pragma unroll
                    for (int bj = 0; bj < 2; ++bj)
#pragma unroll
                        for (int n = 0; n < 2; ++n) { const f32x4 v = acc[ai][bj][m][n]; u32x2 w; w.x = cvt_pk_bf16(v[0], v[1]); w.y = cvt_pk_bf16(v[2], v[3]); *(u32x2*)(rowp + bj * HALF + 32 * n) = w; } }
        }
    }
};
struct EpiRelu2 {
    static constexpr bool AFTER_DRAIN = false;
    __host__ __device__ static int bperm(int R) { return (R & ~31) + perm32(R & 31); }
    bf16_t* O; int ldc;
    __device__ __forceinline__ void operator()(const f32x4 (&acc)[2][2][4][2], const Unit& u, int wr, int wc, int fr, int fq) const {
        const int row0 = u.pm * BM + wr * 64 + fr, col0 = u.pn * BM + wc * 32 + 8 * fq;
#pragma unroll
        for (int ai = 0; ai < 2; ++ai)
#pragma unroll
            for (int m = 0; m < 4; ++m) { bf16_t* rowp = O + (size_t)(row0 + ai * HALF + m * 16) * ldc + col0;
#pragma unroll
                for (int bj = 0; bj < 2; ++bj) { f32x4 v0 = acc[ai][bj][m][0], v1 = acc[ai][bj][m][1];
                    v0 = __builtin_elementwise_max(v0, (f32x4){0.f, 0.f, 0.f, 0.f}); v1 = __builtin_elementwise_max(v1, (f32x4){0.f, 0.f, 0.f, 0.f}); v0 = v0 * v0; v1 = v1 * v1;
                    u32x4 w; w.x = cvt_pk_bf16(v0[0], v0[1]); w.y = cvt_pk_bf16(v0[2], v0[3]); w.z = cvt_pk_bf16(v1[0], v1[1]); w.w = cvt_pk_bf16(v1[2], v1[3]);
                    *(u32x4*)(rowp + bj * HALF) = w; } }
    }
};
struct EpiF32 {
    static constexpr bool AFTER_DRAIN = false;
    __host__ __device__ static int bperm(int R) { return R; }
    float* C; int ldc;
    __device__ __forceinline__ void operator()(const f32x4 (&acc)[2][2][4][2], const Unit& u, int wr, int wc, int fr, int fq) const {
        const int row0 = u.pm * BM + wr * 64 + fr, col0 = u.pn * BM + wc * 32 + 4 * fq;
#pragma unroll
        for (int ai = 0; ai < 2; ++ai)
#pragma unroll
            for (int m = 0; m < 4; ++m) { float* rowp = C + (size_t)(row0 + ai * HALF + m * 16) * ldc + col0;
#pragma unroll
                for (int bj = 0; bj < 2; ++bj)
#pragma unroll
                    for (int n = 0; n < 2; ++n) *(f32x4*)(rowp + bj * HALF + n * 16) = acc[ai][bj][m][n]; }
    }
};

template <class Epi, class Sched, bool ALIGN_EPI = false, bool SP2 = false>
__device__ __forceinline__ void gemm_phase(PG8_LAS unsigned char* lds, const Gemm g, const Sched& S, const Epi& E) {
    const int tid = threadIdx.x, wid = __builtin_amdgcn_readfirstlane(tid >> 6), lane = tid & 63, wr = wid >> 2, wc = wid & 3, fr = lane & 15, fq = lane >> 4;
    const int K = g.K, nt = K / BK;
    unsigned voffA[2], voffB[2];
#pragma unroll
    for (int i = 0; i < 2; ++i) { int R, C; stage_rc(tid * 16 + i * 8192, R, C); const int Rb = Epi::bperm(R);
        voffA[i] = (unsigned)(R * K + C) * 2u; voffB[i] = (unsigned)(Rb * K + C) * 2u; }
    const size_t kstep = (size_t)(BK * 2);
    const size_t hstep = (size_t)HALF * K * 2;
    const size_t tstep = 2 * hstep;
    const unsigned ldsw = (unsigned)wid * 1024u;
    const int aoff = lds_byte(wr * 64 + fr, fq * 8), boff = lds_byte(wc * 32 + fr, fq * 8);
#define PG8_SA(b, h) (((b) * 2 + (h)) * HTB)
#define PG8_SB(b, h) ((4 + (b) * 2 + (h)) * HTB)
#define PG8_STAGE(bufoff, gbase, voff) do { _Pragma("unroll") for (int _i = 0; _i < 2; ++_i) \
        __builtin_amdgcn_global_load_lds((const unsigned*)((const char*)(gbase) + (voff)[_i]), (PG8_LAS unsigned*)(lds + (bufoff) + ldsw + _i * 8192), 16, 0, 0); } while (0)
#define PG8_LDA(dst, b, h) do { _Pragma("unroll") for (int m = 0; m < 4; ++m) _Pragma("unroll") for (int k = 0; k < 2; ++k) dst[m][k] = *(const PG8_LAS bf16x8*)(lds + PG8_SA(b, h) + aoff + m * 2048 + k * 1024); } while (0)
#define PG8_LDB(dst, b, h) do { _Pragma("unroll") for (int n = 0; n < 2; ++n) _Pragma("unroll") for (int k = 0; k < 2; ++k) dst[n][k] = *(const PG8_LAS bf16x8*)(lds + PG8_SB(b, h) + boff + n * 2048 + k * 1024); } while (0)
#define PG8_MMA(ai, bj, At, Bt) do { __builtin_amdgcn_s_setprio(1); _Pragma("unroll") for (int m = 0; m < 4; ++m) _Pragma("unroll") for (int n = 0; n < 2; ++n) _Pragma("unroll") for (int k = 0; k < 2; ++k) \
        acc[ai][bj][m][n] = __builtin_amdgcn_mfma_f32_16x16x32_bf16(Bt[n][k], At[m][k], acc[ai][bj][m][n], 0, 0, 0); __builtin_amdgcn_s_setprio(0); } while (0)
#define PG8_WAIT_V(n) asm volatile("s_waitcnt vmcnt(" #n ")" ::: "memory")
#define PG8_WAIT_L(n) asm volatile("s_waitcnt lgkmcnt(" #n ")" ::: "memory")
#define PG8_BAR __builtin_amdgcn_s_barrier()
#define PG8_SCHED __builtin_amdgcn_sched_barrier(0)
    Unit cur, nxt; int ui = 0;
    if (!S.next(0, cur)) return;
    f32x4 acc[2][2][4][2];
#pragma unroll
    for (int a = 0; a < 2; ++a)
#pragma unroll
        for (int b = 0; b < 2; ++b)
#pragma unroll
            for (int m = 0; m < 4; ++m)
#pragma unroll
                for (int n = 0; n < 2; ++n) acc[a][b][m][n] = (f32x4){0.f, 0.f, 0.f, 0.f};
    bf16x8 At[4][2], B0[2][2], B1[2][2];
    const char* cA = (const char*)g.A + (size_t)cur.pm * tstep; const char* cB = (const char*)g.Bt + (size_t)cur.pn * tstep;
    S.a_ready(cur);
    if constexpr (SP2) {
        PG8_STAGE(PG8_SB(0, 0), cB, voffB); PG8_STAGE(PG8_SB(0, 1), cB + hstep, voffB); PG8_STAGE(PG8_SA(0, 0), cA, voffA); PG8_STAGE(PG8_SA(0, 1), cA + hstep, voffA);
        if (wr == 1) PG8_BAR;
        PG8_WAIT_V(2); PG8_BAR;
        PG8_STAGE(PG8_SB(1, 0), cB + kstep, voffB); PG8_STAGE(PG8_SA(1, 0), cA + kstep, voffA); PG8_STAGE(PG8_SB(1, 1), cB + hstep + kstep, voffB);
        PG8_WAIT_V(6); PG8_BAR;
    } else {
        PG8_STAGE(PG8_SB(0, 0), cB, voffB); PG8_STAGE(PG8_SA(0, 0), cA, voffA); PG8_STAGE(PG8_SB(0, 1), cB + hstep, voffB); PG8_STAGE(PG8_SA(0, 1), cA + hstep, voffA);
        if (wr == 1) PG8_BAR;
        PG8_WAIT_V(4); PG8_BAR;
        PG8_STAGE(PG8_SB(1, 0), cB + kstep, voffB); PG8_STAGE(PG8_SA(1, 0), cA + kstep, voffA); PG8_STAGE(PG8_SB(1, 1), cB + hstep + kstep, voffB);
        PG8_WAIT_V(6); PG8_BAR;
    }
    for (;;) {
        const bool has_next = S.next(ui + 1, nxt);
        const char* nA = has_next ? (const char*)g.A + (size_t)nxt.pm * tstep : cA; const char* nB = has_next ? (const char*)g.Bt + (size_t)nxt.pn * tstep : cB;
        for (int t = 0; t < nt; t += 2) {
            const bool last = (t == nt - 2);
            const char* a1 = cA + (size_t)(t + 1) * kstep;
            const char* a2 = last ? nA : cA + (size_t)(t + 2) * kstep; const char* b2 = last ? nB : cB + (size_t)(t + 2) * kstep;
            const char* a3 = a2 + kstep; const char* b3 = b2 + kstep;
            if (last && has_next) S.a_ready(nxt);
            if constexpr (SP2) {
            PG8_LDB(B0, 0, 0); PG8_LDB(B1, 0, 1); PG8_SCHED; PG8_LDA(At, 0, 0); PG8_STAGE(PG8_SA(1, 1), a1 + hstep, voffA);
            PG8_WAIT_V(8); PG8_WAIT_L(0); PG8_BAR; PG8_MMA(0, 0, At, B0); PG8_MMA(0, 1, At, B1); PG8_BAR; PG8_SCHED;
            PG8_LDA(At, 0, 1); PG8_STAGE(PG8_SB(0, 0), b2, voffB); PG8_STAGE(PG8_SB(0, 1), b2 + hstep, voffB); PG8_STAGE(PG8_SA(0, 0), a2, voffA);
            PG8_WAIT_V(8); PG8_WAIT_L(0); PG8_BAR; PG8_MMA(1, 0, At, B0); PG8_MMA(1, 1, At, B1); PG8_BAR; PG8_SCHED;
            PG8_LDB(B0, 1, 0); PG8_LDB(B1, 1, 1); PG8_SCHED; PG8_LDA(At, 1, 0); PG8_STAGE(PG8_SA(0, 1), a2 + hstep, voffA);
            PG8_WAIT_V(8); PG8_WAIT_L(0); PG8_BAR; PG8_MMA(0, 0, At, B0); PG8_MMA(0, 1, At, B1); PG8_BAR; PG8_SCHED;
            PG8_LDA(At, 1, 1); PG8_STAGE(PG8_SB(1, 0), b3, voffB); PG8_STAGE(PG8_SB(1, 1), b3 + hstep, voffB); PG8_STAGE(PG8_SA(1, 0), a3, voffA);
            PG8_WAIT_V(8); PG8_WAIT_L(0); PG8_BAR; PG8_MMA(1, 0, At, B0); PG8_MMA(1, 1, At, B1); PG8_BAR; PG8_SCHED;
            } else {
            PG8_LDB(B0, 0, 0); PG8_SCHED; PG8_LDA(At, 0, 0); PG8_STAGE(PG8_SA(1, 1), a1 + hstep, voffA);
            PG8_WAIT_L(8); PG8_BAR; PG8_WAIT_L(0); PG8_MMA(0, 0, At, B0); PG8_BAR; PG8_SCHED;
            PG8_LDB(B1, 0, 1); PG8_STAGE(PG8_SB(0, 0), b2, voffB);
            PG8_BAR; PG8_WAIT_L(0); PG8_MMA(0, 1, At, B1); PG8_BAR;
            PG8_LDA(At, 0, 1); PG8_STAGE(PG8_SA(0, 0), a2, voffA);
            PG8_BAR; PG8_WAIT_L(0); PG8_MMA(1, 0, At, B0); PG8_BAR; PG8_SCHED;
            PG8_STAGE(PG8_SB(0, 1), b2 + hstep, voffB);
            PG8_WAIT_V(6); PG8_BAR; PG8_MMA(1, 1, At, B1); PG8_BAR;
            PG8_LDB(B0, 1, 0); PG8_SCHED; PG8_LDA(At, 1, 0); PG8_STAGE(PG8_SA(0, 1), a2 + hstep, voffA);
            PG8_WAIT_L(8); PG8_BAR; PG8_WAIT_L(0); PG8_MMA(0, 0, At, B0); PG8_BAR; PG8_SCHED;
            PG8_LDB(B1, 1, 1); PG8_STAGE(PG8_SB(1, 0), b3, voffB);
            PG8_BAR; PG8_WAIT_L(0); PG8_MMA(0, 1, At, B1); PG8_BAR;
            PG8_LDA(At, 1, 1); PG8_STAGE(PG8_SA(1, 0), a3, voffA);
            PG8_BAR; PG8_WAIT_L(0); PG8_MMA(1, 0, At, B0); PG8_BAR; PG8_SCHED;
            PG8_STAGE(PG8_SB(1, 1), b3 + hstep, voffB);
            PG8_WAIT_V(6); PG8_BAR; PG8_MMA(1, 1, At, B1); PG8_BAR;
            }
        }
        if constexpr (ALIGN_EPI) { if (wr == 0) PG8_BAR; }
        if constexpr (!Epi::AFTER_DRAIN) { E(acc, cur, wr, wc, fr, fq); S.done(cur); }
        if (!has_next) break;
#pragma unroll
        for (int a = 0; a < 2; ++a)
#pragma unroll
            for (int b = 0; b < 2; ++b)
#pragma unroll
                for (int m = 0; m < 4; ++m)
#pragma unroll
                    for (int n = 0; n < 2; ++n) acc[a][b][m][n] = (f32x4){0.f, 0.f, 0.f, 0.f};
        cur = nxt; cA = nA; cB = nB; ++ui;
        if constexpr (ALIGN_EPI) { if (wr == 1) PG8_BAR; }
    }
    PG8_WAIT_V(0);
    if constexpr (!ALIGN_EPI) { if (wr == 0) PG8_BAR; }
    PG8_BAR;
    if constexpr (Epi::AFTER_DRAIN) { E.fused(acc, cur, wr, wc, fr, fq, lds, wid, lane); S.done(cur); }
#undef PG8_SA
#undef PG8_SB
#undef PG8_STAGE
#undef PG8_LDA
#undef PG8_LDB
#undef PG8_MMA
#undef PG8_WAIT_V
#undef PG8_WAIT_L
#undef PG8_BAR
#undef PG8_SCHED
}
}

constexpr int RING_OFF = 0, RING_BYTES = 131072;
constexpr int LDSCTL_OFF = RING_BYTES, MISC_OFF = LDSCTL_OFF + 320;
constexpr int LDS_BYTES = 147456;
constexpr int NWAVES = 8;
constexpr int CW_TMO = 0, CW_CODE = 1, CW_BAR = 4096, CW_QUEUE = 8192;

#define GAS __attribute__((address_space(1)))
#define LAS __attribute__((address_space(3)))
typedef unsigned short bf16;
typedef unsigned v4u __attribute__((ext_vector_type(4)));
typedef float f32x4 __attribute__((ext_vector_type(4)));
typedef short bf16x8 __attribute__((ext_vector_type(8)));
typedef GAS unsigned gu32;
typedef GAS unsigned long long gu64;
#define RLX_AGENT __ATOMIC_RELAXED, __HIP_MEMORY_SCOPE_AGENT
#define LDS_WAIT() asm volatile("s_waitcnt lgkmcnt(0)" ::: "memory")
#define VM_WAIT() asm volatile("s_waitcnt vmcnt(0)" ::: "memory")
__device__ __forceinline__ unsigned long long rt() { return __builtin_amdgcn_s_memrealtime(); }
__device__ __forceinline__ unsigned f2bf(float f) { unsigned u = __builtin_bit_cast(unsigned, f); return (u + 0x7fffu + ((u >> 16) & 1u)) >> 16; }
__device__ __forceinline__ unsigned pk2(float lo, float hi) { return f2bf(lo) | (f2bf(hi) << 16); }
#define XB_TMO      128
#define XB_XCNT(j)  (256  + 64 * (j))
#define XB_XSUB(j)  (1280 + 64 * (j))
#define XB_XGEN(j)  (2304 + 64 * (j))
#define XB_TOP      3328
#define XB_TOPGEN   3392
#define XCD_BAR_WORDS 3456
#define XB_SPIN_CAP (1u << 18)

__device__ __forceinline__ unsigned xb_ld(unsigned* p)              { return __hip_atomic_load(p, __ATOMIC_RELAXED, __HIP_MEMORY_SCOPE_AGENT); }
__device__ __forceinline__ unsigned xb_add(unsigned* p, unsigned v) { return __hip_atomic_fetch_add(p, v, __ATOMIC_RELAXED, __HIP_MEMORY_SCOPE_AGENT); }
__device__ __forceinline__ unsigned xb_xcc_id() { return (unsigned)__builtin_amdgcn_s_getreg((3 << 11) | 20) & 0xFu; }
#define XB_SPIN(cond, bar) do { unsigned _sp = 0; while (cond) { __builtin_amdgcn_s_sleep(1); \
    if ((++_sp & 255u) == 0u) { if (xb_ld(&(bar)[XB_TMO])) break; if (_sp > XB_SPIN_CAP) { atomicAdd(&(bar)[XB_TMO], 1u); break; } } } } while (0)

struct XcdBarrier {
    unsigned* bar; unsigned x;
    volatile LAS unsigned* st;
};

__device__ __forceinline__ XcdBarrier xcd_barrier_post(unsigned* bar, volatile LAS unsigned* st) {
    XcdBarrier b; b.bar = bar; b.x = xb_xcc_id(); b.st = st;
    if (threadIdx.x == 0) (void)xb_add(&bar[XB_XCNT(b.x)], 1u);
    return b;
}
__device__ __forceinline__ void xcd_barrier_complete(unsigned* bar, unsigned x, unsigned& nloc, unsigned& nx) {
    const unsigned G = gridDim.x * gridDim.y * gridDim.z;
    unsigned sum, cnt, mine, sp = 0u;
    for (;;) {
        sum = 0u; cnt = 0u; mine = 0u;
#pragma unroll
        for (unsigned j = 0; j < 16; ++j) { const unsigned c = xb_ld(&bar[XB_XCNT(j)]); sum += c; cnt += (c > 0u) ? 1u : 0u; mine = (j == x) ? c : mine; }
        if (sum == G) break;
        __builtin_amdgcn_s_sleep(1);
        if ((++sp & 255u) == 0u) { if (xb_ld(&bar[XB_TMO])) break; if (sp > XB_SPIN_CAP) { atomicAdd(&bar[XB_TMO], 1u); break; } }
    }
    nloc = mine > 0u ? mine : 1u; nx = cnt > 0u ? cnt : 1u;
}

__device__ __forceinline__ void xcd_barrier(const XcdBarrier& b) {
    asm volatile("s_waitcnt vmcnt(0)" ::: "memory");
    __syncthreads();
    if (threadIdx.x == 0) {
        unsigned* bar = b.bar;
        __builtin_amdgcn_s_waitcnt(0);
        unsigned nloc = b.st[0], nx = b.st[1];
        if (nloc == 0u) { xcd_barrier_complete(bar, b.x, nloc, nx); b.st[0] = nloc; b.st[1] = nx; }
        const unsigned old = xb_add(&bar[XB_XSUB(b.x)], 1u);
        const unsigned gen = old / nloc;
        if (old + 1u == (gen + 1u) * nloc) {
            __builtin_amdgcn_fence(__ATOMIC_RELEASE, "agent");
            asm volatile("s_waitcnt vmcnt(0)" ::: "memory");
            const unsigned og = xb_add(&bar[XB_TOP], 1u);
            const unsigned tg = og / nx;
            if (og + 1u == (tg + 1u) * nx) xb_add(&bar[XB_TOPGEN], 1u);
            else XB_SPIN(xb_ld(&bar[XB_TOPGEN]) == tg, bar);
            __builtin_amdgcn_fence(__ATOMIC_ACQUIRE, "agent");
            xb_add(&bar[XB_XGEN(b.x)], 1u);
            asm volatile("s_waitcnt vmcnt(0)" ::: "memory");
        } else {
            XB_SPIN(xb_ld(&bar[XB_XGEN(b.x)]) == gen, bar);
            __builtin_amdgcn_fence(__ATOMIC_ACQUIRE, "agent");
            asm volatile("s_waitcnt vmcnt(0)" ::: "memory");
        }
    }
    __syncthreads();
}

namespace mlstm {
typedef short bf16x8 __attribute__((ext_vector_type(8)));
typedef float f32x4 __attribute__((ext_vector_type(4)));
typedef unsigned u32x4 __attribute__((ext_vector_type(4)));
typedef unsigned u32x2 __attribute__((ext_vector_type(2)));
constexpr int LD = 72, LDB = LD * 2;
constexpr int QS = 0, KS = 64 * LDB, KWT = 2 * 64 * LDB, PS = 3 * 64 * LDB, VT = 4 * 64 * LDB, CT = VT + 128 * LDB, VEC = CT + 128 * LDB;
constexpr int VPAR = 8 * 64 * 4, NV = VEC + 2 * VPAR, QN = NV + 256, LDS_END = QN + 256;
constexpr float LOG2E = 1.4426950408889634f;
#define MBAR() asm volatile("s_waitcnt vmcnt(0) lgkmcnt(0)\n\ts_barrier" ::: "memory")
#define LBAR() asm volatile("s_waitcnt lgkmcnt(0)\n\ts_barrier" ::: "memory")
__device__ __forceinline__ float silu(float x) { return x / (1.f + __expf(-x)); }

__device__ __forceinline__ void chain(int bh, const bf16* MQ, const bf16* MK, const bf16* MV, const bf16* MO, const float* GATES, const float* conv_w, const float* conv_b, const float* mnorm, bf16* MIX, LAS unsigned char* lds) {
    const int tid = threadIdx.x, lane = tid & 63, fr = lane & 15, fq = lane >> 4; const int w = __builtin_amdgcn_readfirstlane(tid >> 6);
    const int b = bh >> 2, h = bh & 3; const size_t rowb = (size_t)b * SEQ;
    const int mt = w >> 1, nh = w & 1;
    for (int i = tid; i < (128 * LDB) / 4; i += 512) ((LAS unsigned*)(lds + CT))[i] = 0u;
    if (tid < 64) ((LAS float*)(lds + NV))[tid] = 0.f;
    f32x4 Cacc[4];
#pragma unroll
    for (int i = 0; i < 4; ++i) Cacc[i] = (f32x4){0.f, 0.f, 0.f, 0.f};
    float m_old = 0.f;
    const int tens = tid >> 8, d2 = tid & 31, tg = (tid >> 5) & 7;
    float cw[4][2], cb[2];
#pragma unroll
    for (int j = 0; j < 4; ++j) { cw[j][0] = conv_w[j * 512 + tens * 256 + h * 64 + 2 * d2]; cw[j][1] = conv_w[j * 512 + tens * 256 + h * 64 + 2 * d2 + 1]; }
    cb[0] = conv_b[tens * 256 + h * 64 + 2 * d2]; cb[1] = conv_b[tens * 256 + h * 64 + 2 * d2 + 1];
    const bf16* qksrc = (tens ? MK : MQ) + rowb * 256 + h * 64 + 2 * d2;
    const int vp = tid & 63, sg = tid >> 6;
    const bf16* vsrc = MV + rowb * 512 + h * 128 + 2 * vp;
    float gn[4];
#pragma unroll
    for (int i = 0; i < 4; ++i) gn[i] = mnorm[h * 128 + 16 * (4 * nh + i) + fr];
    unsigned xr[11], vr[8];
#define MLOAD(c) do { _Pragma("unroll") for (int i = 0; i < 11; ++i) { const int t = (c) * 64 + 8 * tg - 3 + i; xr[i] = (t >= 0) ? *(const unsigned*)(qksrc + (size_t)t * 256) : 0u; } \
        _Pragma("unroll") for (int i = 0; i < 8; ++i) vr[i] = *(const unsigned*)(vsrc + (size_t)((c) * 64 + 8 * sg + i) * 512); } while (0)
    MLOAD(0);
    MBAR();
    for (int c = 0; c < SEQ / 64; ++c) {
        const size_t row0 = rowb + (size_t)c * 64;
        LAS float* vec = (LAS float*)(lds + VEC + (c & 1) * VPAR);
        if (w == 0) {
            const float iv = GATES[(row0 + lane) * 8 + h], lfv = GATES[(row0 + lane) * 8 + 4 + h];
            float bs = lfv;
#pragma unroll
            for (int o = 1; o < 64; o <<= 1) { const float t = __shfl_up(bs, o); if (lane >= o) bs += t; }
            const float g = __shfl(bs, 63), av = iv - bs;
            float pm = av;
#pragma unroll
            for (int o = 1; o < 64; o <<= 1) { const float t = __shfl_up(pm, o); if (lane >= o) pm = fmaxf(pm, t); }
            const float r = fmaxf(m_old, pm), logw = g + av;
            float mx = logw;
#pragma unroll
            for (int o = 1; o < 64; o <<= 1) mx = fmaxf(mx, __shfl_xor(mx, o));
            const float m_new = fmaxf(g + m_old, mx);
            vec[lane] = av * LOG2E; vec[64 + lane] = r * LOG2E; vec[128 + lane] = expf(logw - m_new); vec[192 + lane] = expf(m_old - r); vec[256 + lane] = expf(-(bs + r));
            vec[320 + lane] = 0.f; vec[384 + lane] = 0.f; if (lane == 0) vec[448] = expf(g + m_old - m_new);
            m_old = m_new;
        }
        MBAR();
        {
            float y[8][2];
#pragma unroll
            for (int t = 0; t < 8; ++t) { float a0 = cb[0], a1 = cb[1];
#pragma unroll
                for (int j = 0; j < 4; ++j) { a0 += cw[j][0] * bf2f(xr[t + j] & 0xffffu); a1 += cw[j][1] * bf2f(xr[t + j] >> 16); }
                y[t][0] = silu(a0); y[t][1] = silu(a1); }
            if (tens == 0) {
#pragma unroll
                for (int t = 0; t < 8; ++t) *(LAS unsigned*)(lds + QS + (8 * tg + t) * LDB + 4 * d2) = pk2(y[t][0] * 0.125f, y[t][1] * 0.125f);
            } else {
                float kw[8][2];
#pragma unroll
                for (int t = 0; t < 8; ++t) { *(LAS unsigned*)(lds + KS + (8 * tg + t) * LDB + 4 * d2) = pk2(y[t][0], y[t][1]); const float wt = vec[128 + 8 * tg + t]; kw[t][0] = y[t][0] * wt; kw[t][1] = y[t][1] * wt; }
#pragma unroll
                for (int e = 0; e < 2; ++e) { u32x4 o; o.x = pk2(kw[0][e], kw[1][e]); o.y = pk2(kw[2][e], kw[3][e]); o.z = pk2(kw[4][e], kw[5][e]); o.w = pk2(kw[6][e], kw[7][e]);
                    *(LAS u32x4*)(lds + KWT + (2 * d2 + e) * LDB + 16 * tg) = o; }
            }
#pragma unroll
            for (int e = 0; e < 2; ++e) { u32x4 o;
                o.x = e ? ((vr[0] >> 16) | (vr[1] & 0xffff0000u)) : ((vr[0] & 0xffffu) | (vr[1] << 16)); o.y = e ? ((vr[2] >> 16) | (vr[3] & 0xffff0000u)) : ((vr[2] & 0xffffu) | (vr[3] << 16));
                o.z = e ? ((vr[4] >> 16) | (vr[5] & 0xffff0000u)) : ((vr[4] & 0xffffu) | (vr[5] << 16)); o.w = e ? ((vr[6] >> 16) | (vr[7] & 0xffff0000u)) : ((vr[6] & 0xffffu) | (vr[7] << 16));
                *(LAS u32x4*)(lds + VT + (2 * vp + e) * LDB + 16 * sg) = o; }
        }
        if (c + 1 < SEQ / 64) MLOAD(c + 1);
        LBAR();
        f32x4 inter[4];
        {
            bf16x8 qa[2];
#pragma unroll
            for (int k = 0; k < 2; ++k) qa[k] = *(LAS bf16x8*)(lds + QS + (16 * mt + fr) * LDB + (32 * k + 8 * fq) * 2);
            float ps[4] = {0.f, 0.f, 0.f, 0.f};
#pragma unroll
            for (int i = 0; i < 2; ++i) { const int nt = 2 * nh + i; f32x4 s = (f32x4){0.f, 0.f, 0.f, 0.f};
#pragma unroll
                for (int k = 0; k < 2; ++k) { const bf16x8 kb = *(LAS bf16x8*)(lds + KS + (16 * nt + fr) * LDB + (32 * k + 8 * fq) * 2); s = __builtin_amdgcn_mfma_f32_16x16x32_bf16(qa[k], kb, s, 0, 0, 0); }
                const int sc = 16 * nt + fr; const float a2 = vec[sc];
#pragma unroll
                for (int e = 0; e < 4; ++e) { const int j = 16 * mt + 4 * fq + e; const float p = (sc <= j) ? s[e] * __builtin_amdgcn_exp2f(a2 - vec[64 + j]) : 0.f; ps[e] += p;
                    *(LAS unsigned short*)(lds + PS + j * LDB + sc * 2) = (unsigned short)f2bf(p); } }
#pragma unroll
            for (int e = 0; e < 4; ++e) { float v = ps[e]; v += __shfl_xor(v, 1); v += __shfl_xor(v, 2); v += __shfl_xor(v, 4); v += __shfl_xor(v, 8); if (fr == 0) atomicAdd((float*)&vec[320 + 16 * mt + 4 * fq + e], v); }
#pragma unroll
            for (int i = 0; i < 4; ++i) { const int nt = 4 * nh + i; inter[i] = (f32x4){0.f, 0.f, 0.f, 0.f};
#pragma unroll
                for (int k = 0; k < 2; ++k) { const bf16x8 cb8 = *(LAS bf16x8*)(lds + CT + (16 * nt + fr) * LDB + (32 * k + 8 * fq) * 2); inter[i] = __builtin_amdgcn_mfma_f32_16x16x32_bf16(qa[k], cb8, inter[i], 0, 0, 0); } }
            {
                const int j = tid >> 3, part = tid & 7; const bf16x8 q8 = *(LAS bf16x8*)(lds + QS + j * LDB + part * 16); const LAS float* nv = (LAS float*)(lds + NV) + part * 8; float a = 0.f;
#pragma unroll
                for (int e = 0; e < 8; ++e) a += bf2f((unsigned short)q8[e]) * nv[e];
                a += __shfl_xor(a, 1); a += __shfl_xor(a, 2); a += __shfl_xor(a, 4); if (part == 0) ((LAS float*)(lds + QN))[j] = a;
            }
        }
        LBAR();
        float hv[4][4];
        {
            bf16x8 pa[2];
#pragma unroll
            for (int k = 0; k < 2; ++k) pa[k] = *(LAS bf16x8*)(lds + PS + (16 * mt + fr) * LDB + (32 * k + 8 * fq) * 2);
            float wi[4], rd[4], sq[4];
#pragma unroll
            for (int e = 0; e < 4; ++e) { const int j = 16 * mt + 4 * fq + e; wi[e] = vec[192 + j]; const float den = wi[e] * ((LAS float*)(lds + QN))[j] + vec[320 + j]; rd[e] = 1.f / fmaxf(fabsf(den), vec[256 + j]); sq[e] = 0.f; }
#pragma unroll
            for (int i = 0; i < 4; ++i) { const int nt = 4 * nh + i; f32x4 x = (f32x4){0.f, 0.f, 0.f, 0.f};
#pragma unroll
                for (int k = 0; k < 2; ++k) { const bf16x8 vb = *(LAS bf16x8*)(lds + VT + (16 * nt + fr) * LDB + (32 * k + 8 * fq) * 2); x = __builtin_amdgcn_mfma_f32_16x16x32_bf16(pa[k], vb, x, 0, 0, 0); }
#pragma unroll
                for (int e = 0; e < 4; ++e) { const float t = (wi[e] * inter[i][e] + x[e]) * rd[e]; hv[i][e] = t; sq[e] += t * t; } }
#pragma unroll
            for (int e = 0; e < 4; ++e) { float v = sq[e]; v += __shfl_xor(v, 1); v += __shfl_xor(v, 2); v += __shfl_xor(v, 4); v += __shfl_xor(v, 8); if (fr == 0) atomicAdd((float*)&vec[384 + 16 * mt + 4 * fq + e], v); }
        }
        {
            const float decay = vec[448];
            bf16x8 ka[2];
#pragma unroll
            for (int k = 0; k < 2; ++k) ka[k] = *(LAS bf16x8*)(lds + KWT + (16 * mt + fr) * LDB + (32 * k + 8 * fq) * 2);
#pragma unroll
            for (int i = 0; i < 4; ++i) { const int nt = 4 * nh + i; Cacc[i] = Cacc[i] * decay;
#pragma unroll
                for (int k = 0; k < 2; ++k) { const bf16x8 vb = *(LAS bf16x8*)(lds + VT + (16 * nt + fr) * LDB + (32 * k + 8 * fq) * 2); Cacc[i] = __builtin_amdgcn_mfma_f32_16x16x32_bf16(ka[k], vb, Cacc[i], 0, 0, 0); }
                u32x2 o; o.x = pk2(Cacc[i][0], Cacc[i][1]); o.y = pk2(Cacc[i][2], Cacc[i][3]); *(LAS u32x2*)(lds + CT + (16 * nt + fr) * LDB + (16 * mt + 4 * fq) * 2) = o; }
            if (tid < 64) { float a = 0.f;
#pragma unroll
                for (int q = 0; q < 8; ++q) { const bf16x8 k8 = *(LAS bf16x8*)(lds + KWT + tid * LDB + q * 16);
#pragma unroll
                    for (int e = 0; e < 8; ++e) a += bf2f((unsigned short)k8[e]); }
                LAS float* nv = (LAS float*)(lds + NV); nv[tid] = decay * nv[tid] + a; }
        }
        LBAR();
#pragma unroll
        for (int e = 0; e < 4; ++e) { const int j = 16 * mt + 4 * fq + e; const float rstd = 1.0f / sqrtf(vec[384 + j] * (1.f / 128.f) + EPS);
#pragma unroll
            for (int i = 0; i < 4; ++i) { const int v = 16 * (4 * nh + i) + fr; const float og = bf2f(MO[(row0 + j) * 512 + h * 128 + v]);
                MIX[(row0 + j) * 1024 + 512 + h * 128 + v] = (bf16)f2bf(hv[i][e] * rstd * gn[i] / (1.f + __expf(-og))); } }
    }
    MBAR();
#undef MLOAD
}
#undef MBAR
#undef LBAR
}

namespace dattn {
typedef short bf16x8 __attribute__((ext_vector_type(8)));
typedef short s16x4 __attribute__((ext_vector_type(4)));
typedef short v4i16_t __attribute__((ext_vector_type(4)));
typedef float f32x16 __attribute__((ext_vector_type(16)));
typedef unsigned u32x4 __attribute__((ext_vector_type(4)));
typedef float f32x2_t __attribute__((ext_vector_type(2))); typedef __bf16 bf16x2_t __attribute__((ext_vector_type(2)));
constexpr int SLOTB = 32768, NSLOT = 3, OFF_K2 = 8192, OFF_V = 16384, LDS_WS = NSLOT * SLOTB, LDS_X = 0, LDS_STG = 65536, LDS_END = LDS_WS + 8 * 256;
__device__ __forceinline__ int crow(int r, int hi) { return (r & 3) + 8 * (r >> 2) + 4 * hi; }
__device__ __forceinline__ void glds16(const void* gsrc, unsigned lds_dst) { unsigned keep;
    asm volatile("s_mov_b32 %0, m0\n\ts_mov_b32 m0, %2\n\ts_nop 0\n\tglobal_load_lds_dwordx4 %1, off\n\ts_mov_b32 m0, %0" : "=&s"(keep) : "v"(gsrc), "s"(lds_dst) : "memory"); }
__device__ __forceinline__ unsigned cvtpk_s(float lo, float hi) { f32x2_t v = {lo, hi}; bf16x2_t b = __builtin_convertvector(v, bf16x2_t); return __builtin_bit_cast(unsigned, b); }
__device__ __forceinline__ s16x4 vtr(LAS const unsigned char* p) { return __builtin_bit_cast(s16x4, __builtin_amdgcn_ds_read_tr16_b64_v4i16((LAS v4i16_t*)p)); }
#define DWAIT_BAR(N) asm volatile("s_waitcnt vmcnt(" #N ") lgkmcnt(0)\n\ts_barrier" ::: "memory")
__device__ __forceinline__ float rowmax(const f32x16& p0, const f32x16& p1) {
    float a = fmaxf(fmaxf(p0[0], p0[1]), p1[0]), b = fmaxf(fmaxf(p0[2], p0[3]), p1[1]); a = fmaxf(fmaxf(a, p1[2]), p1[3]);
#pragma unroll
    for (int r = 4; r < 16; r += 4) { a = fmaxf(fmaxf(a, p0[r]), p0[r + 1]); b = fmaxf(fmaxf(b, p0[r + 2]), p0[r + 3]); a = fmaxf(fmaxf(a, p1[r]), p1[r + 1]); b = fmaxf(fmaxf(b, p1[r + 2]), p1[r + 3]); }
    const float m = fmaxf(a, b);
    auto rr = __builtin_amdgcn_permlane32_swap(__float_as_uint(m), __float_as_uint(m), false, false);
    return fmaxf(__uint_as_float(rr[0]), __uint_as_float(rr[1]));
}
template <int THRL>
__device__ __forceinline__ void unit(int bh, int qb, const bf16* Q, const bf16* K, const bf16* V, bf16* MIX, float lam, const float* dnorm, LAS unsigned char* lds) {
    const int tid = threadIdx.x, lane = tid & 63, r32 = lane & 31, hi = lane >> 5; const int wid = __builtin_amdgcn_readfirstlane(tid >> 6);
    const int c = wid >> 2, qs = wid & 3, b = bh >> 2, h = bh & 3;
    const size_t rowbase = (size_t)b * SEQ; const int q0 = qb * 128 + qs * 32;
    const bf16* Kh = K + rowbase * 512 + h * 128; const bf16* Vh = V + rowbase * 512 + h * 128;
    const unsigned lds0 = (unsigned)(uintptr_t)lds;
    LAS float* wsf = (LAS float*)(lds + LDS_WS) + wid * 64;
    const bf16* ksrc = Kh + (size_t)lane * 512 + wid * 8;
    const bf16* vsrc = Vh + (size_t)(16 * (wid & 3) + (lane >> 2)) * 512 + (wid >> 2) * 32 + (lane & 3) * 8;
    const unsigned kdst = lds0 + wid * 1024, vdst = lds0 + OFF_V + wid * 1024;
#define DMA_T(t, slot) do { const size_t go_ = (size_t)(t) * 64 * 512; \
        glds16(ksrc + go_, (unsigned)__builtin_amdgcn_readfirstlane(kdst + (slot))); glds16(ksrc + go_ + 64, (unsigned)__builtin_amdgcn_readfirstlane(kdst + (slot) + OFF_K2)); \
        glds16(vsrc + go_, (unsigned)__builtin_amdgcn_readfirstlane(vdst + (slot))); glds16(vsrc + go_ + 64, (unsigned)__builtin_amdgcn_readfirstlane(vdst + (slot) + 8192)); } while (0)
    const int NT = 2 * qb + 2;
    DMA_T(0, 0); DMA_T(1, SLOTB);
    bf16x8 qr[4];
    { const bf16* Qw = Q + (rowbase + q0 + r32) * 512 + h * 128 + c * 64 + hi * 8;
#pragma unroll
      for (int d0 = 0; d0 < 4; ++d0) qr[d0] = *(const bf16x8*)(Qw + d0 * 16); }
    float gnv[4];
#pragma unroll
    for (int d0 = 0; d0 < 4; ++d0) gnv[d0] = dnorm[32 * d0 + r32] * (1.f - LAM_INIT);
    float mhat = 0.f, l_reg = 0.f; f32x16 o[4];
#pragma unroll
    for (int d0 = 0; d0 < 4; ++d0) o[d0] = f32x16{};
    f32x16 negm = f32x16{};
    const int qrel = qs * 32 + r32;
    const int vboff = OFF_V + ((lane >> 4) & 1) * 32 + (lane & 3) * 8 + (4 * hi + ((lane & 15) >> 2)) * 64;
    int slot = 0, slot_free = 2 * SLOTB;
    for (int t = 0; t < NT; ++t) {
        if (t + 1 < NT) DWAIT_BAR(4); else DWAIT_BAR(0);
        if (t + 2 < NT) DMA_T(t + 2, slot_free);
        const int jb = t - 2 * qb;
        if (!(jb == 1 && qs < 2)) {
            f32x16 p0, p1;
            { LAS const unsigned char* kb = lds + slot + c * OFF_K2 + hi * 1024 + r32 * 16;
#pragma unroll
              for (int d0 = 0; d0 < 4; ++d0) { const bf16x8 b0 = *(LAS const bf16x8*)(kb + d0 * 2048), b1 = *(LAS const bf16x8*)(kb + d0 * 2048 + 512);
                  if (d0 == 0) { p0 = __builtin_amdgcn_mfma_f32_32x32x16_bf16(b0, qr[0], negm, 0, 0, 0); p1 = __builtin_amdgcn_mfma_f32_32x32x16_bf16(b1, qr[0], negm, 0, 0, 0); }
                  else { p0 = __builtin_amdgcn_mfma_f32_32x32x16_bf16(b0, qr[d0], p0, 0, 0, 0); p1 = __builtin_amdgcn_mfma_f32_32x32x16_bf16(b1, qr[d0], p1, 0, 0, 0); } } }
            if (jb >= 0) { const int kb_ = 64 * jb + 4 * hi;
#pragma unroll
                for (int r = 0; r < 16; ++r) { const int kv = kb_ + (r & 3) + 8 * (r >> 2); if (kv > qrel) p0[r] = -INFINITY; if (kv + 32 > qrel) p1[r] = -INFINITY; } }
            const float rm = rowmax(p0, p1);
            if (t == 0 || __any(rm > (float)THRL)) {
                const float dl = (t == 0) ? rm : fmaxf(rm, 0.f); mhat += dl;
#pragma unroll
                for (int r = 0; r < 16; ++r) { p0[r] -= dl; p1[r] -= dl; negm[r] = -mhat; }
                const float f = __builtin_amdgcn_exp2f(-dl); l_reg *= f;
                if (t > 0) { if (hi == 0) wsf[r32] = f; asm volatile("s_waitcnt lgkmcnt(0)" ::: "memory");
#pragma unroll
                    for (int r = 0; r < 16; ++r) { const float fr_ = wsf[crow(r, hi)];
#pragma unroll
                        for (int d0 = 0; d0 < 4; ++d0) o[d0][r] *= fr_; }
                    asm volatile("s_waitcnt lgkmcnt(0)" ::: "memory"); }
            }
            float sacc = 0.f;
#pragma unroll
            for (int r = 0; r < 16; ++r) { p0[r] = __builtin_amdgcn_exp2f(p0[r]); p1[r] = __builtin_amdgcn_exp2f(p1[r]); sacc += p0[r] + p1[r]; }
            l_reg += sacc;
            u32x4 pw[4];
#pragma unroll
            for (int q4 = 0; q4 < 4; ++q4) { pw[0][q4] = cvtpk_s(p0[2 * q4], p0[2 * q4 + 1]); pw[1][q4] = cvtpk_s(p0[8 + 2 * q4], p0[8 + 2 * q4 + 1]); pw[2][q4] = cvtpk_s(p1[2 * q4], p1[2 * q4 + 1]); pw[3][q4] = cvtpk_s(p1[8 + 2 * q4], p1[8 + 2 * q4 + 1]); }
            LAS const unsigned char* vb = lds + slot + vboff;
#pragma unroll
            for (int d0 = 0; d0 < 4; ++d0)
#pragma unroll
                for (int ks = 0; ks < 4; ++ks) { const s16x4 lo = vtr(vb + d0 * 4096 + ks * 1024), hh = vtr(vb + d0 * 4096 + ks * 1024 + 512);
                    const bf16x8 vf = (bf16x8){lo[0], lo[1], lo[2], lo[3], hh[0], hh[1], hh[2], hh[3]};
                    o[d0] = __builtin_amdgcn_mfma_f32_32x32x16_bf16(__builtin_bit_cast(bf16x8, pw[ks]), vf, o[d0], 0, 0, 0); }
        }
        slot_free = slot_free == 2 * SLOTB ? 0 : slot_free + SLOTB; slot = slot == 2 * SLOTB ? 0 : slot + SLOTB;
    }
    { auto rr = __builtin_amdgcn_permlane32_swap(__float_as_uint(l_reg), __float_as_uint(l_reg), false, false); l_reg = __uint_as_float(rr[0]) + __uint_as_float(rr[1]); }
    if (hi == 0) wsf[32 + r32] = l_reg;
    asm volatile("s_waitcnt lgkmcnt(0)" ::: "memory");
    float rli[16];
#pragma unroll
    for (int r = 0; r < 16; ++r) rli[r] = 1.0f / wsf[32 + crow(r, hi)];
    DWAIT_BAR(0);
    LAS float* X = (LAS float*)(lds + LDS_X) + qs * 4096;
    if (c == 1) {
#pragma unroll
        for (int d0 = 0; d0 < 4; ++d0)
#pragma unroll
            for (int r = 0; r < 16; ++r) X[(d0 * 16 + r) * 64 + lane] = o[d0][r] * rli[r];
    }
    DWAIT_BAR(0);
    if (c == 0) {
        float ss[16];
#pragma unroll
        for (int r = 0; r < 16; ++r) { ss[r] = 0.f;
#pragma unroll
            for (int d0 = 0; d0 < 4; ++d0) { const float v = o[d0][r] * rli[r] - lam * X[(d0 * 16 + r) * 64 + lane]; o[d0][r] = v; ss[r] += v * v; } }
#pragma unroll
        for (int r = 0; r < 16; ++r) { float v = ss[r]; v += __shfl_xor(v, 1); v += __shfl_xor(v, 2); v += __shfl_xor(v, 4); v += __shfl_xor(v, 8); v += __shfl_xor(v, 16); ss[r] = 1.0f / sqrtf(v * (1.f / 128.f) + EPS); }
        LAS unsigned short* stg = (LAS unsigned short*)(lds + LDS_STG) + qs * 4096;
#pragma unroll
        for (int r = 0; r < 16; ++r) { const int orow = crow(r, hi);
#pragma unroll
            for (int d0 = 0; d0 < 4; ++d0) stg[orow * 128 + d0 * 32 + r32] = (unsigned short)f2bf(o[d0][r] * ss[r] * gnv[d0]); }
        asm volatile("s_waitcnt lgkmcnt(0)" ::: "memory");
        bf16* Ow = MIX + (rowbase + q0) * 1024 + h * 128;
#pragma unroll
        for (int i = 0; i < 8; ++i) { const int id = i * 64 + lane, row = id >> 4, ch = id & 15; const u32x4 v = *(LAS const u32x4*)((LAS const unsigned char*)stg + row * 256 + ch * 16); *(u32x4*)(Ow + (size_t)row * 1024 + ch * 8) = v; }
    }
    DWAIT_BAR(0);
#undef DMA_T
}
#undef DWAIT_BAR
}

__device__ __forceinline__ void p0_transpose_item(const float* W, int K, int N, int ldW, const float* g, bf16* WT, LAS float* scr, int item, int lane) {
    const int nblk = N / 32, kb = item / nblk, nb = item % nblk, k0 = 64 * kb, n0 = 32 * nb;
#pragma unroll 8
    for (int i = 0; i < 32; ++i) { const int kk = 2 * i + (lane >> 5); scr[kk * 33 + (lane & 31)] = W[(size_t)(k0 + kk) * ldW + n0 + (lane & 31)] * (g ? g[k0 + kk] : 1.f); }
    LDS_WAIT(); asm volatile("" ::: "memory");
    const int c = lane & 7;
#pragma unroll
    for (int j = 0; j < 4; ++j) { const int n = (lane >> 3) + 8 * j; const LAS float* s = scr + (8 * c) * 33 + n;
        v4u o; o.x = pk2(s[0 * 33], s[1 * 33]); o.y = pk2(s[2 * 33], s[3 * 33]); o.z = pk2(s[4 * 33], s[5 * 33]); o.w = pk2(s[6 * 33], s[7 * 33]);
        *(GAS v4u*)(WT + (size_t)(n0 + n) * K + k0 + 8 * c) = o; }
    LDS_WAIT(); asm volatile("" ::: "memory");
}
__device__ __forceinline__ void p0_row(const float* x, const float* WG, const float* b_i, const float* b_f, bf16* XN, float* GATES, int row, int lane) {
    const GAS f32x4* xr = (const GAS f32x4*)(x + (size_t)row * DM) + lane;
    f32x4 v[4]; float ss = 0.f;
#pragma unroll
    for (int j = 0; j < 4; ++j) { v[j] = xr[64 * j]; ss += (v[j].x * v[j].x + v[j].y * v[j].y) + (v[j].z * v[j].z + v[j].w * v[j].w); }
    const float rstd = 1.0f / sqrtf(wave_sum(ss) * (1.f / DM) + EPS);
    GAS unsigned long long* o8 = (GAS unsigned long long*)(XN + (size_t)row * DM) + lane;
#pragma unroll
    for (int j = 0; j < 4; ++j) o8[64 * j] = (unsigned long long)pk2(v[j].x * rstd, v[j].y * rstd) | ((unsigned long long)pk2(v[j].z * rstd, v[j].w * rstd) << 32);
    float mine = 0.f;
#pragma unroll
    for (int q = 0; q < 8; ++q) {
        const GAS f32x4* wr = (const GAS f32x4*)(WG + q * 1024) + lane; float a = 0.f;
#pragma unroll
        for (int j = 0; j < 4; ++j) { const f32x4 w = wr[64 * j]; a += (v[j].x * w.x + v[j].y * w.y) + (v[j].z * w.z + v[j].w * w.w); }
        a = wave_sum(a) * rstd; if (lane == q) mine = a;
    }
    if (lane < 4) GATES[(size_t)row * 8 + lane] = mine + b_i[lane];
    else if (lane < 8) { const float z = mine + b_f[lane - 4]; GATES[(size_t)row * 8 + lane] = fminf(z, 0.f) - log1pf(expf(-fabsf(z))); }
}
__device__ __forceinline__ void rownorm1(const float* x, const float* T1, const float* gpost, float* X1, bf16* X1N, int row, int lane) {
    const GAS f32x4* tr = (const GAS f32x4*)(T1 + (size_t)row * DM) + lane; const GAS f32x4* xr = (const GAS f32x4*)(x + (size_t)row * DM) + lane; const GAS f32x4* gr = (const GAS f32x4*)gpost + lane;
    f32x4 t[4]; float ss = 0.f;
#pragma unroll
    for (int j = 0; j < 4; ++j) { t[j] = tr[64 * j]; ss += (t[j].x * t[j].x + t[j].y * t[j].y) + (t[j].z * t[j].z + t[j].w * t[j].w); }
    const float rstd = 1.0f / sqrtf(wave_sum(ss) * (1.f / DM) + EPS); float s2 = 0.f;
#pragma unroll
    for (int j = 0; j < 4; ++j) { t[j] = xr[64 * j] + t[j] * rstd * gr[64 * j]; s2 += (t[j].x * t[j].x + t[j].y * t[j].y) + (t[j].z * t[j].z + t[j].w * t[j].w); }
    const float rstd2 = 1.0f / sqrtf(wave_sum(s2) * (1.f / DM) + EPS);
    GAS f32x4* o = (GAS f32x4*)(X1 + (size_t)row * DM) + lane; GAS unsigned long long* o8 = (GAS unsigned long long*)(X1N + (size_t)row * DM) + lane;
#pragma unroll
    for (int j = 0; j < 4; ++j) { o[64 * j] = t[j]; o8[64 * j] = (unsigned long long)pk2(t[j].x * rstd2, t[j].y * rstd2) | ((unsigned long long)pk2(t[j].z * rstd2, t[j].w * rstd2) << 32); }
}
__device__ __forceinline__ void rownorm2(const float* T2, const float* g, float* out, int row, int lane) {
    const GAS f32x4* tr = (const GAS f32x4*)(T2 + (size_t)row * DM) + lane; const GAS f32x4* gr = (const GAS f32x4*)g + lane; GAS f32x4* o = (GAS f32x4*)(out + (size_t)row * DM) + lane;
    f32x4 t[4]; float ss = 0.f;
#pragma unroll
    for (int j = 0; j < 4; ++j) { t[j] = tr[64 * j]; ss += (t[j].x * t[j].x + t[j].y * t[j].y) + (t[j].z * t[j].z + t[j].w * t[j].w); }
    const float rstd = 1.0f / sqrtf(wave_sum(ss) * (1.f / DM) + EPS);
#pragma unroll
    for (int j = 0; j < 4; ++j) o[64 * j] = o[64 * j] + t[j] * rstd * gr[64 * j];
}

struct Args { const float* in[19]; float* out; unsigned char* ws; int ph_lo, ph_hi, use_cg, pad; };
constexpr int N_PHASES = 8;

__global__ void __launch_bounds__(NWAVES * 64, 2) mk_fwd(Args args) {
    extern __shared__ __attribute__((aligned(16))) unsigned char lds_raw[];
    LAS unsigned char* lds = (LAS unsigned char*)lds_raw;
    volatile LAS unsigned* MISC = (volatile LAS unsigned*)(lds + MISC_OFF);
    const int tid = threadIdx.x, lane = tid & 63, wave = __builtin_amdgcn_readfirstlane(tid >> 6);
    const int G = gridDim.x; const int bx = blockIdx.x; const int vcu = (G % 8 == 0) ? (bx % 8) * (G / 8) + bx / 8 : bx;
    unsigned char* ws = args.ws;
    gu32* ctl = (gu32*)(ws + WS_CTL);
    const float* x = args.in[0]; float* out = args.out;
    bf16 *W1 = (bf16*)(ws + WS_W1), *W2 = (bf16*)(ws + WS_W2), *W3 = (bf16*)(ws + WS_W3), *W4 = (bf16*)(ws + WS_W4), *XN = (bf16*)(ws + WS_XN);
    bf16 *Qb = (bf16*)(ws + WS_Q), *Kb = (bf16*)(ws + WS_K), *Vb = (bf16*)(ws + WS_V), *MQ = (bf16*)(ws + WS_MQ), *MK = (bf16*)(ws + WS_MK), *MV = (bf16*)(ws + WS_MV), *MO = (bf16*)(ws + WS_MO);
    bf16 *MIX = (bf16*)(ws + WS_MIX), *X1N = (bf16*)(ws + WS_X1N), *U = (bf16*)(ws + WS_U);
    float *WG = (float*)(ws + WS_WG), *GATES = (float*)(ws + WS_GATES), *T1 = (float*)(ws + WS_T1), *T2 = (float*)(ws + WS_T2), *ROPE = (float*)(ws + WS_ROPE);
    for (int u = tid; u < (LDS_BYTES - LDSCTL_OFF) / 4; u += NWAVES * 64) ((LAS unsigned*)(lds + LDSCTL_OFF))[u] = 0u;
    __syncthreads();
    XcdBarrier bar; bar.bar = (unsigned*)(ctl + CW_BAR); bar.x = 0; bar.st = nullptr;
    if (!args.use_cg) bar = xcd_barrier_post((unsigned*)(ctl + CW_BAR), MISC + 8);
#define GRID_BAR() do { if (args.use_cg) cg::this_grid().sync(); else xcd_barrier(bar); } while (0)
    const int lo = args.ph_lo, hi = args.ph_hi;
#define IN(k) (lo <= (k) && (k) < hi)
#define BOTH(k) (IN(k) && IN((k) + 1))
    const int gw = vcu * NWAVES + wave, NGW = G * NWAVES;

    if (IN(0)) {
        LAS float* scr = (LAS float*)(lds + RING_OFF + wave * 16384);
        constexpr int I1 = (DM / 64) * (NPROJ / 32), I2 = (DM / 64) * (DM / 32), I3 = (DM / 64) * (FF / 32), I4 = (FF / 64) * (DM / 32);
        for (int it = gw; it < I1 + I2 + I3 + I4; it += NGW) {
            int r = it;
            if (r < I1) { p0_transpose_item(args.in[2], DM, NPROJ, INW, args.in[1], W1, scr, r, lane); continue; } r -= I1;
            if (r < I2) { p0_transpose_item(args.in[13], DM, DM, DM, nullptr, W2, scr, r, lane); continue; } r -= I2;
            if (r < I3) { p0_transpose_item(args.in[16], DM, FF, FF, args.in[15], W3, scr, r, lane); continue; } r -= I3;
            p0_transpose_item(args.in[17], FF, DM, DM, nullptr, W4, scr, r, lane);
        }
        {
            const int i = bx * (NWAVES * 64) + tid;
            if (i < 8 * 1024) { const int j = i >> 10, k = i & 1023; WG[i] = args.in[1][k] * args.in[2][(size_t)k * INW + NPROJ + j]; }
            if (i < SEQ * 32) { const int pos = i >> 5, j = i & 31; const float inv = (float)pow(10000.0, -(double)(2 * j) / 64.0); const float ang = (float)pos * inv;
                ROPE[2 * i] = (float)cos((double)ang); ROPE[2 * i + 1] = (float)sin((double)ang); }
        }
        GRID_BAR();
        for (int m = gw; m < M; m += NGW) p0_row(x, WG, args.in[5], args.in[6], XN, GATES, m, lane);
        if (BOTH(0)) GRID_BAR();
    }
    if (IN(1)) {
        pg8::Gemm g{XN, W1, M, NPROJ, DM}; pg8::StaticOrder S; S.init(M, NPROJ, G, bx);
        pg8::EpiProj E{Qb, Kb, Vb, MQ, MK, MV, MO, ROPE};
        pg8::gemm_phase<pg8::EpiProj, pg8::StaticOrder, true, true>(lds + RING_OFF, g, S, E);
        if (BOTH(1)) GRID_BAR();
    }
    if (IN(2)) {
        if (bx < 128) mlstm::chain(bx, MQ, MK, MV, MO, GATES, args.in[3], args.in[4], args.in[12], MIX, lds);
        const float lam = expf(wave_sum(args.in[7][lane] * args.in[8][lane])) - expf(wave_sum(args.in[9][lane] * args.in[10][lane])) + LAM_INIT;
        for (int k = 0; k < 8; ++k) {
            const int q = (bx + k) & 7;
            for (;;) {
                if (tid == 0) MISC[0] = __hip_atomic_fetch_add(ctl + CW_QUEUE + 64 * q, 1u, RLX_AGENT);
                __syncthreads();
                const unsigned idx = MISC[0];
                __syncthreads();
                if (idx >= 256u) break;
                dattn::unit<8>(q + 8 * (int)(idx >> 4), 15 - (int)(idx & 15u), Qb, Kb, Vb, MIX, lam, args.in[11], lds);
            }
        }
        if (BOTH(2)) GRID_BAR();
    }
    if (IN(3)) {
        pg8::Gemm g{MIX, W2, M, DM, DM}; pg8::StaticOrder S; S.init(M, DM, G, bx);
        pg8::EpiF32 E{T1, DM};
        pg8::gemm_phase<pg8::EpiF32, pg8::StaticOrder, true, true>(lds + RING_OFF, g, S, E);
        if (BOTH(3)) GRID_BAR();
    }
    if (IN(4)) {
        for (int m = gw; m < M; m += NGW) rownorm1(x, T1, args.in[14], out, X1N, m, lane);
        if (BOTH(4)) GRID_BAR();
    }
    if (IN(5)) {
        pg8::Gemm g{X1N, W3, M, FF, DM}; pg8::StaticOrder S; S.init(M, FF, G, bx);
        pg8::EpiRelu2 E{U, FF};
        pg8::gemm_phase<pg8::EpiRelu2, pg8::StaticOrder, true, true>(lds + RING_OFF, g, S, E);
        if (BOTH(5)) GRID_BAR();
    }
    if (IN(6)) {
        pg8::Gemm g{U, W4, M, DM, FF}; pg8::StaticOrder S; S.init(M, DM, G, bx);
        pg8::EpiF32 E{T2, DM};
        pg8::gemm_phase<pg8::EpiF32, pg8::StaticOrder, true, true>(lds + RING_OFF, g, S, E);
        if (BOTH(6)) GRID_BAR();
    }
    if (IN(7)) { for (int m = gw; m < M; m += NGW) rownorm2(T2, args.in[18], out, m, lane); }
#undef IN
#undef BOTH
}

extern "C" void kernel_launch(void* const* d_in, const int* in_sizes, int n_in, void* d_out, int out_size, void* d_ws, size_t ws_size, hipStream_t stream) {
    static int grid = 0;
    if (grid == 0) {
        if (n_in != 19 || in_sizes[0] != M * DM || out_size != M * DM || ws_size < WS_END) { fprintf(stderr, "kernel_launch: unexpected problem shape (n_in %d, ws %zu)\n", n_in, ws_size); grid = -1; return; }
        int dev = 0, cus = 0, per_cu = 0;
        if (hipGetDevice(&dev) != hipSuccess || hipDeviceGetAttribute(&cus, hipDeviceAttributeMultiprocessorCount, dev) != hipSuccess) { grid = -1; return; }
        if (hipFuncSetAttribute((const void*)mk_fwd, hipFuncAttributeMaxDynamicSharedMemorySize, LDS_BYTES) != hipSuccess) { fprintf(stderr, "kernel_launch: hipFuncSetAttribute failed\n"); grid = -1; return; }
        if (hipOccupancyMaxActiveBlocksPerMultiprocessor(&per_cu, (const void*)mk_fwd, NWAVES * 64, LDS_BYTES) != hipSuccess || per_cu < 1) { fprintf(stderr, "kernel_launch: occupancy query says %d\n", per_cu); per_cu = 1; }
        (void)hipGetLastError();
        grid = cus;
    }
    if (grid < 0) return;
    (void)hipMemsetAsync((char*)d_ws + WS_CTL, 0, CTL_ZERO_BYTES, stream);
    unsigned char* ws = (unsigned char*)d_ws; float* out = (float*)d_out;
    Args a{};
    for (int i = 0; i < 19; ++i) a.in[i] = (const float*)d_in[i];
    a.out = out; a.ws = ws; a.use_cg = 1;
    auto launch = [&](int lo, int hi) {
        a.ph_lo = lo; a.ph_hi = hi; void* kargs[] = {&a};
        hipError_t e = hipLaunchCooperativeKernel((const void*)mk_fwd, dim3(grid), dim3(NWAVES * 64), kargs, LDS_BYTES, stream);
        if (e != hipSuccess) fprintf(stderr, "kernel_launch: cooperative launch failed: %s (grid %d)\n", hipGetErrorString(e), grid);
    };
    launch(0, 8);
}
```

```cpp
#include <hip/hip_runtime.h>
#include <hip/hip_cooperative_groups.h>
#include <cstdint>
#include <cstdio>
namespace cg = cooperative_groups;

typedef unsigned short bf16_t;
typedef float f32x16 __attribute__((ext_vector_type(16)));

constexpr int NB = 32, SEQ = 2048, DM = 1024, M = NB * SEQ, NPROJ = 3072, INW = 3080, FF = 4096;
constexpr float EPS = 1e-6f;
constexpr float LAM_INIT = 0.2f;
constexpr float QSCALE = 0.125f * 1.4426950408889634f;

constexpr size_t MiB = 1u << 20;
constexpr size_t WS_CTL = 0, CTL_ZERO_BYTES = 1 * MiB, WS_ROPE = 1 * MiB, WS_WG = 1 * MiB + 512 * 1024, WS_GATES = 2 * MiB;
constexpr size_t WS_W1 = 4 * MiB, WS_W2 = 10 * MiB, WS_W3 = 12 * MiB, WS_W4 = 20 * MiB;
constexpr size_t WS_XN = 32 * MiB;
constexpr size_t WS_Q = 160 * MiB, WS_K = 224 * MiB, WS_V = 288 * MiB, WS_MQ = 352 * MiB, WS_MK = 384 * MiB, WS_MV = 416 * MiB, WS_MO = 480 * MiB;
constexpr size_t WS_MIX = 544 * MiB, WS_X1N = 672 * MiB, WS_U = 32 * MiB, WS_END = 800 * MiB;
constexpr size_t WS_T1 = 160 * MiB, WS_T2 = 544 * MiB;


__device__ __forceinline__ float bf2f(unsigned h) { return __uint_as_float(h << 16); }

__device__ __forceinline__ float wave_sum(float v) {
#pragma unroll
    for (int o = 1; o < 64; o <<= 1) v += __shfl_xor(v, o);
    return v;
}
namespace pg8 {
#define PG8_LAS __attribute__((address_space(3)))
typedef unsigned short bf16_t;
typedef short bf16x8 __attribute__((ext_vector_type(8)));
typedef float f32x4 __attribute__((ext_vector_type(4)));
typedef unsigned u32x4 __attribute__((ext_vector_type(4)));
constexpr int BM = 256, BK = 64, HALF = 128, HTB = HALF * BK * 2  , STAGE_BYTES = 8 * HTB, NXCD = 8, WGM = 8;

__host__ __device__ __forceinline__ int lds_byte(int r, int c) { const int st = (r >> 4) * 2 + (c >> 5), rr = r & 15, cc = c & 31, ob = rr * 64 + cc * 2; return st * 1024 + (ob ^ (((ob >> 9) & 1) << 5)); }
__host__ __device__ __forceinline__ void stage_rc(int b, int& R, int& C) { const int st = b / 1024, sb = b % 1024, swz = sb ^ (((sb >> 9) & 1) << 5); R = (st >> 1) * 16 + swz / 64; C = (st & 1) * 32 + (swz % 64) / 2; }
__host__ __device__ __forceinline__ int perm32(int rho) { const int n = rho >> 4, i = rho & 15; return 8 * (i >> 2) + 4 * n + (i & 3); }

struct Unit { int pm, pn; };
struct Gemm { const bf16_t* A; const bf16_t* Bt; int M, N, K; };

struct StaticOrder {
    int nM, nN, nwg, G, c;
    __host__ __device__ void init(int M, int N, int G_, int c_) { nM = M / BM; nN = N / BM; nwg = nM * nN; G = G_; c = c_; }
    __host__ __device__ bool next(int i, Unit& u) const {
        const long L = (long)i * G + c; if (L >= nwg) return false;
        int wgid = (int)L; { const int q = nwg / NXCD, r = nwg % NXCD, xcd = wgid % NXCD, off = wgid / NXCD; wgid = (xcd < r ? xcd * (q + 1) : r * (q + 1) + (xcd - r) * q) + off; }
        const int nig = WGM * nN, gid = wgid / nig, fm = gid * WGM, gsz = (nM - fm) < WGM ? (nM - fm) : WGM;
        u.pm = fm + ((wgid % nig) % gsz); u.pn = (wgid % nig) / gsz; return true;
    }
    __device__ __forceinline__ void a_ready(const Unit&) const {}
    __device__ __forceinline__ void done(const Unit&) const {}
};

__device__ __forceinline__ unsigned cvt_pk_bf16(float lo, float hi) { unsigned r; asm volatile("v_cvt_pk_bf16_f32 %0, %1, %2" : "=v"(r) : "v"(lo), "v"(hi)); return r; }
typedef unsigned u32x2 __attribute__((ext_vector_type(2)));

struct EpiProj {
    static constexpr bool AFTER_DRAIN = false;
    __host__ __device__ static int bperm(int R) { return 64 * (R >> 6) + 32 * ((R >> 4) & 1) + 16 * ((R >> 5) & 1) + (R & 15); }
    bf16_t *Q, *K, *V, *MQ, *MK, *MV, *MO; const float* rope;
    __device__ __forceinline__ void operator()(const f32x4 (&acc)[2][2][4][2], const Unit& u, int wr, int wc, int fr, int fq) const {
        const int row0 = u.pm * BM + wr * 64 + fr, cw = 64 * (wc >> 1) + 16 * (wc & 1) + 4 * fq, pn = u.pn;
        if (pn < 4) {
            bf16_t* dst = pn < 2 ? Q : K; const int c0 = (pn & 1) * 256 + cw; const float sc = pn < 2 ? QSCALE : 1.f;
#pragma unroll
            for (int ai = 0; ai < 2; ++ai)
#pragma unroll
                for (int m = 0; m < 4; ++m) {
                    const int row = row0 + ai * HALF + m * 16; const float* rp = rope + ((row & (SEQ - 1)) * 32 + 16 * (wc & 1) + 4 * fq) * 2;
                    const f32x4 t0 = *(const f32x4*)rp, t1 = *(const f32x4*)(rp + 4);
                    const f32x4 cs = (f32x4){t0[0], t0[2], t1[0], t1[2]} * sc, sn = (f32x4){t0[1], t0[3], t1[1], t1[3]} * sc;
                    bf16_t* rowp = dst + (size_t)row * 512 + c0;
#pragma unroll
                    for (int bj = 0; bj < 2; ++bj) { const f32x4 x1 = acc[ai][bj][m][0], x2 = acc[ai][bj][m][1]; const f32x4 o1 = x1 * cs - x2 * sn, o2 = x2 * cs + x1 * sn;
                        u32x2 w1, w2; w1.x = cvt_pk_bf16(o1[0], o1[1]); w1.y = cvt_pk_bf16(o1[2], o1[3]); w2.x = cvt_pk_bf16(o2[0], o2[1]); w2.y = cvt_pk_bf16(o2[2], o2[3]);
                        *(u32x2*)(rowp + bj * HALF) = w1; *(u32x2*)(rowp + bj * HALF + 32) = w2; }
                }
        } else {
            bf16_t* dst; int ld, c0;
            if (pn < 6) { dst = V; ld = 512; c0 = (pn - 4) * 256; } else if (pn == 6) { dst = MQ; ld = 256; c0 = 0; } else if (pn == 7) { dst = MK; ld = 256; c0 = 0; }
            else if (pn < 10) { dst = MV; ld = 512; c0 = (pn - 8) * 256; } else { dst = MO; ld = 512; c0 = (pn - 10) * 256; }
#pragma unroll
            for (int ai = 0; ai < 2; ++ai)
#pragma unroll
                for (int m = 0; m < 4; ++m) { bf16_t* rowp = dst + (size_t)(row0 + ai * HALF + m * 16) * ld + c0 + cw;
#pragma unroll
                    for (int bj = 0; bj < 2; ++bj)
#pragma unroll
                        for (int n = 0; n < 2; ++n) { const f32x4 v = acc[ai][bj][m][n]; u32x2 w; w.x = cvt_pk_bf16(v[0], v[1]); w.y = cvt_pk_bf16(v[2], v[3]); *(u32x2*)(rowp + bj * HALF + 32 * n) = w; } }
        }
    }
};
struct EpiRelu2 {
    static constexpr bool AFTER_DRAIN = false;
    __host__ __device__ static int bperm(int R) { return (R & ~31) + perm32(R & 31); }
    bf16_t* O; int ldc;
    __device__ __forceinline__ void operator()(const f32x4 (&acc)[2][2][4][2], const Unit& u, int wr, int wc, int fr, int fq) const {
        const int row0 = u.pm * BM + wr * 64 + fr, col0 = u.pn * BM + wc * 32 + 8 * fq;
#pragma unroll
        for (int ai = 0; ai < 2; ++ai)
#pragma unroll
            for (int m = 0; m < 4; ++m) { bf16_t* rowp = O + (size_t)(row0 + ai * HALF + m * 16) * ldc + col0;
#pragma unroll
                for (int bj = 0; bj < 2; ++bj) { f32x4 v0 = acc[ai][bj][m][0], v1 = acc[ai][bj][m][1];
                    v0 = __builtin_elementwise_max(v0, (f32x4){0.f, 0.f, 0.f, 0.f}); v1 = __builtin_elementwise_max(v1, (f32x4){0.f, 0.f, 0.f, 0.f}); v0 = v0 * v0; v1 = v1 * v1;
                    u32x4 w; w.x = cvt_pk_bf16(v0[0], v0[1]); w.y = cvt_pk_bf16(v0[2], v0[3]); w.z = cvt_pk_bf16(v1[0], v1[1]); w.w = cvt_pk_bf16(v1[2], v1[3]);
                    *(u32x4*)(rowp + bj * HALF) = w; } }
    }
};
struct EpiF32 {
    static constexpr bool AFTER_DRAIN = false;
    __host__ __device__ static int bperm(int R) { return R; }
    float* C; int ldc;
    __device__ __forceinline__ void operator()(const f32x4 (&acc)[2][2][4][2], const Unit& u, int wr, int wc, int fr, int fq) const {
        const int row0 = u.pm * BM + wr * 64 + fr, col0 = u.pn * BM + wc * 32 + 4 * fq;
#pragma unroll
        for (int ai = 0; ai < 2; ++ai)
#pragma unroll
            for (int m = 0; m < 4; ++m) { float* rowp = C + (size_t)(row0 + ai * HALF + m * 16) * ldc + col0;
#pragma unroll
                for (int bj = 0; bj < 2; ++bj)
#pragma unroll
                    for (int n = 0; n < 2; ++n) *(f32x4*)(rowp + bj * HALF + n * 16) = acc[ai][bj][m][n]; }
    }
};

template <class Epi, class Sched, bool ALIGN_EPI = false, bool SP2 = false>
__device__ __forceinline__ void gemm_phase(PG8_LAS unsigned char* lds, const Gemm g, const Sched& S, const Epi& E) {
    const int tid = threadIdx.x, wid = __builtin_amdgcn_readfirstlane(tid >> 6), lane = tid & 63, wr = wid >> 2, wc = wid & 3, fr = lane & 15, fq = lane >> 4;
    const int K = g.K, nt = K / BK;
    unsigned voffA[2], voffB[2];
#pragma unroll
    for (int i = 0; i < 2; ++i) { int R, C; stage_rc(tid * 16 + i * 8192, R, C); const int Rb = Epi::bperm(R);
        voffA[i] = (unsigned)(R * K + C) * 2u; voffB[i] = (unsigned)(Rb * K + C) * 2u; }
    const size_t kstep = (size_t)(BK * 2);
    const size_t hstep = (size_t)HALF * K * 2;
    const size_t tstep = 2 * hstep;
    const unsigned ldsw = (unsigned)wid * 1024u;
    const int aoff = lds_byte(wr * 64 + fr, fq * 8), boff = lds_byte(wc * 32 + fr, fq * 8);
#define PG8_SA(b, h) (((b) * 2 + (h)) * HTB)
#define PG8_SB(b, h) ((4 + (b) * 2 + (h)) * HTB)
#define PG8_STAGE(bufoff, gbase, voff) do { _Pragma("unroll") for (int _i = 0; _i < 2; ++_i) \
        __builtin_amdgcn_global_load_lds((const unsigned*)((const char*)(gbase) + (voff)[_i]), (PG8_LAS unsigned*)(lds + (bufoff) + ldsw + _i * 8192), 16, 0, 0); } while (0)
#define PG8_LDA(dst, b, h) do { _Pragma("unroll") for (int m = 0; m < 4; ++m) _Pragma("unroll") for (int k = 0; k < 2; ++k) dst[m][k] = *(const PG8_LAS bf16x8*)(lds + PG8_SA(b, h) + aoff + m * 2048 + k * 1024); } while (0)
#define PG8_LDB(dst, b, h) do { _Pragma("unroll") for (int n = 0; n < 2; ++n) _Pragma("unroll") for (int k = 0; k < 2; ++k) dst[n][k] = *(const PG8_LAS bf16x8*)(lds + PG8_SB(b, h) + boff + n * 2048 + k * 1024); } while (0)
#define PG8_MMA(ai, bj, At, Bt) do { __builtin_amdgcn_s_setprio(1); _Pragma("unroll") for (int m = 0; m < 4; ++m) _Pragma("unroll") for (int n = 0; n < 2; ++n) _Pragma("unroll") for (int k = 0; k < 2; ++k) \
        acc[ai][bj][m][n] = __builtin_amdgcn_mfma_f32_16x16x32_bf16(Bt[n][k], At[m][k], acc[ai][bj][m][n], 0, 0, 0); __builtin_amdgcn_s_setprio(0); } while (0)
#define PG8_WAIT_V(n) asm volatile("s_waitcnt vmcnt(" #n ")" ::: "memory")
#define PG8_WAIT_L(n) asm volatile("s_waitcnt lgkmcnt(" #n ")" ::: "memory")
#define PG8_BAR __builtin_amdgcn_s_barrier()
#define PG8_SCHED __builtin_amdgcn_sched_barrier(0)
    Unit cur, nxt; int ui = 0;
    if (!S.next(0, cur)) return;
    f32x4 acc[2][2][4][2];
#pragma unroll
    for (int a = 0; a < 2; ++a)
#pragma unroll
        for (int b = 0; b < 2; ++b)
#pragma unroll
            for (int m = 0; m < 4; ++m)
#pragma unroll
                for (int n = 0; n < 2; ++n) acc[a][b][m][n] = (f32x4){0.f, 0.f, 0.f, 0.f};
    bf16x8 At[4][2], B0[2][2], B1[2][2];
    const char* cA = (const char*)g.A + (size_t)cur.pm * tstep; const char* cB = (const char*)g.Bt + (size_t)cur.pn * tstep;
    S.a_ready(cur);
    if constexpr (SP2) {
        PG8_STAGE(PG8_SB(0, 0), cB, voffB); PG8_STAGE(PG8_SB(0, 1), cB + hstep, voffB); PG8_STAGE(PG8_SA(0, 0), cA, voffA); PG8_STAGE(PG8_SA(0, 1), cA + hstep, voffA);
        if (wr == 1) PG8_BAR;
        PG8_WAIT_V(2); PG8_BAR;
        PG8_STAGE(PG8_SB(1, 0), cB + kstep, voffB); PG8_STAGE(PG8_SA(1, 0), cA + kstep, voffA); PG8_STAGE(PG8_SB(1, 1), cB + hstep + kstep, voffB);
        PG8_WAIT_V(6); PG8_BAR;
    } else {
        PG8_STAGE(PG8_SB(0, 0), cB, voffB); PG8_STAGE(PG8_SA(0, 0), cA, voffA); PG8_STAGE(PG8_SB(0, 1), cB + hstep, voffB); PG8_STAGE(PG8_SA(0, 1), cA + hstep, voffA);
        if (wr == 1) PG8_BAR;
        PG8_WAIT_V(4); PG8_BAR;
        PG8_STAGE(PG8_SB(1, 0), cB + kstep, voffB); PG8_STAGE(PG8_SA(1, 0), cA + kstep, voffA); PG8_STAGE(PG8_SB(1, 1), cB + hstep + kstep, voffB);
        PG8_WAIT_V(6); PG8_BAR;
    }
    for (;;) {
        const bool has_next = S.next(ui + 1, nxt);
        const char* nA = has_next ? (const char*)g.A + (size_t)nxt.pm * tstep : cA; const char* nB = has_next ? (const char*)g.Bt + (size_t)nxt.pn * tstep : cB;
        for (int t = 0; t < nt; t += 2) {
            const bool last = (t == nt - 2);
            const char* a1 = cA + (size_t)(t + 1) * kstep;
            const char* a2 = last ? nA : cA + (size_t)(t + 2) * kstep; const char* b2 = last ? nB : cB + (size_t)(t + 2) * kstep;
            const char* a3 = a2 + kstep; const char* b3 = b2 + kstep;
            if (last && has_next) S.a_ready(nxt);
            if constexpr (SP2) {
            PG8_LDB(B0, 0, 0); PG8_LDB(B1, 0, 1); PG8_SCHED; PG8_LDA(At, 0, 0); PG8_STAGE(PG8_SA(1, 1), a1 + hstep, voffA);
            PG8_WAIT_V(8); PG8_WAIT_L(0); PG8_BAR; PG8_MMA(0, 0, At, B0); PG8_MMA(0, 1, At, B1); PG8_BAR; PG8_SCHED;
            PG8_LDA(At, 0, 1); PG8_STAGE(PG8_SB(0, 0), b2, voffB); PG8_STAGE(PG8_SB(0, 1), b2 + hstep, voffB); PG8_STAGE(PG8_SA(0, 0), a2, voffA);
            PG8_WAIT_V(8); PG8_WAIT_L(0); PG8_BAR; PG8_MMA(1, 0, At, B0); PG8_MMA(1, 1, At, B1); PG8_BAR; PG8_SCHED;
            PG8_LDB(B0, 1, 0); PG8_LDB(B1, 1, 1); PG8_SCHED; PG8_LDA(At, 1, 0); PG8_STAGE(PG8_SA(0, 1), a2 + hstep, voffA);
            PG8_WAIT_V(8); PG8_WAIT_L(0); PG8_BAR; PG8_MMA(0, 0, At, B0); PG8_MMA(0, 1, At, B1); PG8_BAR; PG8_SCHED;
            PG8_LDA(At, 1, 1); PG8_STAGE(PG8_SB(1, 0), b3, voffB); PG8_STAGE(PG8_SB(1, 1), b3 + hstep, voffB); PG8_STAGE(PG8_SA(1, 0), a3, voffA);
            PG8_WAIT_V(8); PG8_WAIT_L(0); PG8_BAR; PG8_MMA(1, 0, At, B0); PG8_MMA(1, 1, At, B1); PG8_BAR; PG8_SCHED;
            } else {
            PG8_LDB(B0, 0, 0); PG8_SCHED; PG8_LDA(At, 0, 0); PG8_STAGE(PG8_SA(1, 1), a1 + hstep, voffA);
            PG8_WAIT_L(8); PG8_BAR; PG8_WAIT_L(0); PG8_MMA(0, 0, At, B0); PG8_BAR; PG8_SCHED;
            PG8_LDB(B1, 0, 1); PG8_STAGE(PG8_SB(0, 0), b2, voffB);
            PG8_BAR; PG8_WAIT_L(0); PG8_MMA(0, 1, At, B1); PG8_BAR;
            PG8_LDA(At, 0, 1); PG8_STAGE(PG8_SA(0, 0), a2, voffA);
            PG8_BAR; PG8_WAIT_L(0); PG8_MMA(1, 0, At, B0); PG8_BAR; PG8_SCHED;
            PG8_STAGE(PG8_SB(0, 1), b2 + hstep, voffB);
            PG8_WAIT_V(6); PG8_BAR; PG8_MMA(1, 1, At, B1); PG8_BAR;
            PG8_LDB(B0, 1, 0); PG8_SCHED; PG8_LDA(At, 1, 0); PG8_STAGE(PG8_SA(0, 1), a2 + hstep, voffA);
            PG8_WAIT_L(8); PG8_BAR; PG8_WAIT_L(0); PG8_MMA(0, 0, At, B0); PG8_BAR; PG8_SCHED;
            PG8_LDB(B1, 1, 1); PG8_STAGE(PG8_SB(1, 0), b3, voffB);
            PG8_BAR; PG8_WAIT_L(0); PG8_MMA(0, 1, At, B1); PG8_BAR;
            PG8_LDA(At, 1, 1); PG8_STAGE(PG8_SA(1, 0), a3, voffA);
            PG8_BAR; PG8_WAIT_L(0); PG8_MMA(1, 0, At, B0); PG8_BAR; PG8_SCHED;
            PG8_STAGE(PG8_SB(1, 1), b3 + hstep, voffB);
            PG8_WAIT_V(6); PG8_BAR; PG8_MMA(1, 1, At, B1); PG8_BAR;
            }
        }
        if constexpr (ALIGN_EPI) { if (wr == 0) PG8_BAR; }
        if constexpr (!Epi::AFTER_DRAIN) { E(acc, cur, wr, wc, fr, fq); S.done(cur); }
        if (!has_next) break;
#pragma unroll
        for (int a = 0; a < 2; ++a)
#pragma unroll
            for (int b = 0; b < 2; ++b)
#pragma unroll
                for (int m = 0; m < 4; ++m)
#pragma unroll
                    for (int n = 0; n < 2; ++n) acc[a][b][m][n] = (f32x4){0.f, 0.f, 0.f, 0.f};
        cur = nxt; cA = nA; cB = nB; ++ui;
        if constexpr (ALIGN_EPI) { if (wr == 1) PG8_BAR; }
    }
    PG8_WAIT_V(0);
    if constexpr (!ALIGN_EPI) { if (wr == 0) PG8_BAR; }
    PG8_BAR;
    if constexpr (Epi::AFTER_DRAIN) { E.fused(acc, cur, wr, wc, fr, fq, lds, wid, lane); S.done(cur); }
#undef PG8_SA
#undef PG8_SB
#undef PG8_STAGE
#undef PG8_LDA
#undef PG8_LDB
#undef PG8_MMA
#undef PG8_WAIT_V
#undef PG8_WAIT_L
#undef PG8_BAR
#undef PG8_SCHED
}
}

constexpr int RING_OFF = 0, RING_BYTES = 131072;
constexpr int LDSCTL_OFF = RING_BYTES, MISC_OFF = LDSCTL_OFF + 320;
constexpr int LDS_BYTES = 147456;
constexpr int NWAVES = 8;
constexpr int CW_TMO = 0, CW_CODE = 1, CW_BAR = 4096, CW_QUEUE = 8192;

#define GAS __attribute__((address_space(1)))
#define LAS __attribute__((address_space(3)))
typedef unsigned short bf16;
typedef unsigned v4u __attribute__((ext_vector_type(4)));
typedef float f32x4 __attribute__((ext_vector_type(4)));
typedef short bf16x8 __attribute__((ext_vector_type(8)));
typedef GAS unsigned gu32;
typedef GAS unsigned long long gu64;
#define RLX_AGENT __ATOMIC_RELAXED, __HIP_MEMORY_SCOPE_AGENT
#define LDS_WAIT() asm volatile("s_waitcnt lgkmcnt(0)" ::: "memory")
#define VM_WAIT() asm volatile("s_waitcnt vmcnt(0)" ::: "memory")
__device__ __forceinline__ unsigned long long rt() { return __builtin_amdgcn_s_memrealtime(); }
__device__ __forceinline__ unsigned f2bf(float f) { unsigned u = __builtin_bit_cast(unsigned, f); return (u + 0x7fffu + ((u >> 16) & 1u)) >> 16; }
__device__ __forceinline__ unsigned pk2(float lo, float hi) { return f2bf(lo) | (f2bf(hi) << 16); }
#define XB_TMO      128
#define XB_XCNT(j)  (256  + 64 * (j))
#define XB_XSUB(j)  (1280 + 64 * (j))
#define XB_XGEN(j)  (2304 + 64 * (j))
#define XB_TOP      3328
#define XB_TOPGEN   3392
#define XCD_BAR_WORDS 3456
#define XB_SPIN_CAP (1u << 18)

__device__ __forceinline__ unsigned xb_ld(unsigned* p)              { return __hip_atomic_load(p, __ATOMIC_RELAXED, __HIP_MEMORY_SCOPE_AGENT); }
__device__ __forceinline__ unsigned xb_add(unsigned* p, unsigned v) { return __hip_atomic_fetch_add(p, v, __ATOMIC_RELAXED, __HIP_MEMORY_SCOPE_AGENT); }
__device__ __forceinline__ unsigned xb_xcc_id() { return (unsigned)__builtin_amdgcn_s_getreg((3 << 11) | 20) & 0xFu; }
#define XB_SPIN(cond, bar) do { unsigned _sp = 0; while (cond) { __builtin_amdgcn_s_sleep(1); \
    if ((++_sp & 255u) == 0u) { if (xb_ld(&(bar)[XB_TMO])) break; if (_sp > XB_SPIN_CAP) { atomicAdd(&(bar)[XB_TMO], 1u); break; } } } } while (0)

struct XcdBarrier {
    unsigned* bar; unsigned x;
    volatile LAS unsigned* st;
};

__device__ __forceinline__ XcdBarrier xcd_barrier_post(unsigned* bar, volatile LAS unsigned* st) {
    XcdBarrier b; b.bar = bar; b.x = xb_xcc_id(); b.st = st;
    if (threadIdx.x == 0) (void)xb_add(&bar[XB_XCNT(b.x)], 1u);
    return b;
}
__device__ __forceinline__ void xcd_barrier_complete(unsigned* bar, unsigned x, unsigned& nloc, unsigned& nx) {
    const unsigned G = gridDim.x * gridDim.y * gridDim.z;
    unsigned sum, cnt, mine, sp = 0u;
    for (;;) {
        sum = 0u; cnt = 0u; mine = 0u;
#pragma unroll
        for (unsigned j = 0; j < 16; ++j) { const unsigned c = xb_ld(&bar[XB_XCNT(j)]); sum += c; cnt += (c > 0u) ? 1u : 0u; mine = (j == x) ? c : mine; }
        if (sum == G) break;
        __builtin_amdgcn_s_sleep(1);
        if ((++sp & 255u) == 0u) { if (xb_ld(&bar[XB_TMO])) break; if (sp > XB_SPIN_CAP) { atomicAdd(&bar[XB_TMO], 1u); break; } }
    }
    nloc = mine > 0u ? mine : 1u; nx = cnt > 0u ? cnt : 1u;
}

__device__ __forceinline__ void xcd_barrier(const XcdBarrier& b) {
    asm volatile("s_waitcnt vmcnt(0)" ::: "memory");
    __syncthreads();
    if (threadIdx.x == 0) {
        unsigned* bar = b.bar;
        __builtin_amdgcn_s_waitcnt(0);
        unsigned nloc = b.st[0], nx = b.st[1];
        if (nloc == 0u) { xcd_barrier_complete(bar, b.x, nloc, nx); b.st[0] = nloc; b.st[1] = nx; }
        const unsigned old = xb_add(&bar[XB_XSUB(b.x)], 1u);
        const unsigned gen = old / nloc;
        if (old + 1u == (gen + 1u) * nloc) {
            __builtin_amdgcn_fence(__ATOMIC_RELEASE, "agent");
            asm volatile("s_waitcnt vmcnt(0)" ::: "memory");
            const unsigned og = xb_add(&bar[XB_TOP], 1u);
            const unsigned tg = og / nx;
            if (og + 1u == (tg + 1u) * nx) xb_add(&bar[XB_TOPGEN], 1u);
            else XB_SPIN(xb_ld(&bar[XB_TOPGEN]) == tg, bar);
            __builtin_amdgcn_fence(__ATOMIC_ACQUIRE, "agent");
            xb_add(&bar[XB_XGEN(b.x)], 1u);
            asm volatile("s_waitcnt vmcnt(0)" ::: "memory");
        } else {
            XB_SPIN(xb_ld(&bar[XB_XGEN(b.x)]) == gen, bar);
            __builtin_amdgcn_fence(__ATOMIC_ACQUIRE, "agent");
            asm volatile("s_waitcnt vmcnt(0)" ::: "memory");
        }
    }
    __syncthreads();
}

namespace mlstm {
typedef short bf16x8 __attribute__((ext_vector_type(8)));
typedef float f32x4 __attribute__((ext_vector_type(4)));
typedef unsigned u32x4 __attribute__((ext_vector_type(4)));
typedef unsigned u32x2 __attribute__((ext_vector_type(2)));
constexpr int LD = 72, LDB = LD * 2;
constexpr int QS = 0, KS = 64 * LDB, KWT = 2 * 64 * LDB, PS = 3 * 64 * LDB, VT = 4 * 64 * LDB, CT = VT + 128 * LDB, VEC = CT + 128 * LDB;
constexpr int VPAR = 8 * 64 * 4, NV = VEC + 2 * VPAR, QN = NV + 256, LDS_END = QN + 256;
constexpr float LOG2E = 1.4426950408889634f;
#define MBAR() asm volatile("s_waitcnt vmcnt(0) lgkmcnt(0)\n\ts_barrier" ::: "memory")
#define LBAR() asm volatile("s_waitcnt lgkmcnt(0)\n\ts_barrier" ::: "memory")
__device__ __forceinline__ float silu(float x) { return x / (1.f + __expf(-x)); }

__device__ __forceinline__ void chain(int bh, const bf16* MQ, const bf16* MK, const bf16* MV, const bf16* MO, const float* GATES, const float* conv_w, const float* conv_b, const float* mnorm, bf16* MIX, LAS unsigned char* lds) {
    const int tid = threadIdx.x, lane = tid & 63, fr = lane & 15, fq = lane >> 4; const int w = __builtin_amdgcn_readfirstlane(tid >> 6);
    const int b = bh >> 2, h = bh & 3; const size_t rowb = (size_t)b * SEQ;
    const int mt = w >> 1, nh = w & 1;
    for (int i = tid; i < (128 * LDB) / 4; i += 512) ((LAS unsigned*)(lds + CT))[i] = 0u;
    if (tid < 64) ((LAS float*)(lds + NV))[tid] = 0.f;
    f32x4 Cacc[4];
#pragma unroll
    for (int i = 0; i < 4; ++i) Cacc[i] = (f32x4){0.f, 0.f, 0.f, 0.f};
    float m_old = 0.f;
    const int tens = tid >> 8, d2 = tid & 31, tg = (tid >> 5) & 7;
    float cw[4][2], cb[2];
#pragma unroll
    for (int j = 0; j < 4; ++j) { cw[j][0] = conv_w[j * 512 + tens * 256 + h * 64 + 2 * d2]; cw[j][1] = conv_w[j * 512 + tens * 256 + h * 64 + 2 * d2 + 1]; }
    cb[0] = conv_b[tens * 256 + h * 64 + 2 * d2]; cb[1] = conv_b[tens * 256 + h * 64 + 2 * d2 + 1];
    const bf16* qksrc = (tens ? MK : MQ) + rowb * 256 + h * 64 + 2 * d2;
    const int vp = tid & 63, sg = tid >> 6;
    const bf16* vsrc = MV + rowb * 512 + h * 128 + 2 * vp;
    float gn[4];
#pragma unroll
    for (int i = 0; i < 4; ++i) gn[i] = mnorm[h * 128 + 16 * (4 * nh + i) + fr];
    unsigned xr[11], vr[8];
#define MLOAD(c) do { _Pragma("unroll") for (int i = 0; i < 11; ++i) { const int t = (c) * 64 + 8 * tg - 3 + i; xr[i] = (t >= 0) ? *(const unsigned*)(qksrc + (size_t)t * 256) : 0u; } \
        _Pragma("unroll") for (int i = 0; i < 8; ++i) vr[i] = *(const unsigned*)(vsrc + (size_t)((c) * 64 + 8 * sg + i) * 512); } while (0)
    MLOAD(0);
    MBAR();
    for (int c = 0; c < SEQ / 64; ++c) {
        const size_t row0 = rowb + (size_t)c * 64;
        LAS float* vec = (LAS float*)(lds + VEC + (c & 1) * VPAR);
        if (w == 0) {
            const float iv = GATES[(row0 + lane) * 8 + h], lfv = GATES[(row0 + lane) * 8 + 4 + h];
            float bs = lfv;
#pragma unroll
            for (int o = 1; o < 64; o <<= 1) { const float t = __shfl_up(bs, o); if (lane >= o) bs += t; }
            const float g = __shfl(bs, 63), av = iv - bs;
            float pm = av;
#pragma unroll
            for (int o = 1; o < 64; o <<= 1) { const float t = __shfl_up(pm, o); if (lane >= o) pm = fmaxf(pm, t); }
            const float r = fmaxf(m_old, pm), logw = g + av;
            float mx = logw;
#pragma unroll
            for (int o = 1; o < 64; o <<= 1) mx = fmaxf(mx, __shfl_xor(mx, o));
            const float m_new = fmaxf(g + m_old, mx);
            vec[lane] = av * LOG2E; vec[64 + lane] = r * LOG2E; vec[128 + lane] = expf(logw - m_new); vec[192 + lane] = expf(m_old - r); vec[256 + lane] = expf(-(bs + r));
            vec[320 + lane] = 0.f; vec[384 + lane] = 0.f; if (lane == 0) vec[448] = expf(g + m_old - m_new);
            m_old = m_new;
        }
        MBAR();
        {
            float y[8][2];
#pragma unroll
            for (int t = 0; t < 8; ++t) { float a0 = cb[0], a1 = cb[1];
#pragma unroll
                for (int j = 0; j < 4; ++j) { a0 += cw[j][0] * bf2f(xr[t + j] & 0xffffu); a1 += cw[j][1] * bf2f(xr[t + j] >> 16); }
                y[t][0] = silu(a0); y[t][1] = silu(a1); }
            if (tens == 0) {
#pragma unroll
                for (int t = 0; t < 8; ++t) *(LAS unsigned*)(lds + QS + (8 * tg + t) * LDB + 4 * d2) = pk2(y[t][0] * 0.125f, y[t][1] * 0.125f);
            } else {
                float kw[8][2];
#pragma unroll
                for (int t = 0; t < 8; ++t) { *(LAS unsigned*)(lds + KS + (8 * tg + t) * LDB + 4 * d2) = pk2(y[t][0], y[t][1]); const float wt = vec[128 + 8 * tg + t]; kw[t][0] = y[t][0] * wt; kw[t][1] = y[t][1] * wt; }
#pragma unroll
                for (int e = 0; e < 2; ++e) { u32x4 o; o.x = pk2(kw[0][e], kw[1][e]); o.y = pk2(kw[2][e], kw[3][e]); o.z = pk2(kw[4][e], kw[5][e]); o.w = pk2(kw[6][e], kw[7][e]);
                    *(LAS u32x4*)(lds + KWT + (2 * d2 + e) * LDB + 16 * tg) = o; }
            }
#pragma unroll
            for (int e = 0; e < 2; ++e) { u32x4 o;
                o.x = e ? ((vr[0] >> 16) | (vr[1] & 0xffff0000u)) : ((vr[0] & 0xffffu) | (vr[1] << 16)); o.y = e ? ((vr[2] >> 16) | (vr[3] & 0xffff0000u)) : ((vr[2] & 0xffffu) | (vr[3] << 16));
                o.z = e ? ((vr[4] >> 16) | (vr[5] & 0xffff0000u)) : ((vr[4] & 0xffffu) | (vr[5] << 16)); o.w = e ? ((vr[6] >> 16) | (vr[7] & 0xffff0000u)) : ((vr[6] & 0xffffu) | (vr[7] << 16));
                *(LAS u32x4*)(lds + VT + (2 * vp + e) * LDB + 16 * sg) = o; }
        }
        if (c + 1 < SEQ / 64) MLOAD(c + 1);
        LBAR();
        f32x4 inter[4];
        {
            bf16x8 qa[2];
#pragma unroll
            for (int k = 0; k < 2; ++k) qa[k] = *(LAS bf16x8*)(lds + QS + (16 * mt + fr) * LDB + (32 * k + 8 * fq) * 2);
            float ps[4] = {0.f, 0.f, 0.f, 0.f};
#pragma unroll
            for (int i = 0; i < 2; ++i) { const int nt = 2 * nh + i; f32x4 s = (f32x4){0.f, 0.f, 0.f, 0.f};
#pragma unroll
                for (int k = 0; k < 2; ++k) { const bf16x8 kb = *(LAS bf16x8*)(lds + KS + (16 * nt + fr) * LDB + (32 * k + 8 * fq) * 2); s = __builtin_amdgcn_mfma_f32_16x16x32_bf16(qa[k], kb, s, 0, 0, 0); }
                const int sc = 16 * nt + fr; const float a2 = vec[sc];
#pragma unroll
                for (int e = 0; e < 4; ++e) { const int j = 16 * mt + 4 * fq + e; const float p = (sc <= j) ? s[e] * __builtin_amdgcn_exp2f(a2 - vec[64 + j]) : 0.f; ps[e] += p;
                    *(LAS unsigned short*)(lds + PS + j * LDB + sc * 2) = (unsigned short)f2bf(p); } }
#pragma unroll
            for (int e = 0; e < 4; ++e) { float v = ps[e]; v += __shfl_xor(v, 1); v += __shfl_xor(v, 2); v += __shfl_xor(v, 4); v += __shfl_xor(v, 8); if (fr == 0) atomicAdd((float*)&vec[320 + 16 * mt + 4 * fq + e], v); }
#pragma unroll
            for (int i = 0; i < 4; ++i) { const int nt = 4 * nh + i; inter[i] = (f32x4){0.f, 0.f, 0.f, 0.f};
#pragma unroll
                for (int k = 0; k < 2; ++k) { const bf16x8 cb8 = *(LAS bf16x8*)(lds + CT + (16 * nt + fr) * LDB + (32 * k + 8 * fq) * 2); inter[i] = __builtin_amdgcn_mfma_f32_16x16x32_bf16(qa[k], cb8, inter[i], 0, 0, 0); } }
            {
                const int j = tid >> 3, part = tid & 7; const bf16x8 q8 = *(LAS bf16x8*)(lds + QS + j * LDB + part * 16); const LAS float* nv = (LAS float*)(lds + NV) + part * 8; float a = 0.f;
#pragma unroll
                for (int e = 0; e < 8; ++e) a += bf2f((unsigned short)q8[e]) * nv[e];
                a += __shfl_xor(a, 1); a += __shfl_xor(a, 2); a += __shfl_xor(a, 4); if (part == 0) ((LAS float*)(lds + QN))[j] = a;
            }
        }
        LBAR();
        float hv[4][4];
        {
            bf16x8 pa[2];
#pragma unroll
            for (int k = 0; k < 2; ++k) pa[k] = *(LAS bf16x8*)(lds + PS + (16 * mt + fr) * LDB + (32 * k + 8 * fq) * 2);
            float wi[4], rd[4], sq[4];
#pragma unroll
            for (int e = 0; e < 4; ++e) { const int j = 16 * mt + 4 * fq + e; wi[e] = vec[192 + j]; const float den = wi[e] * ((LAS float*)(lds + QN))[j] + vec[320 + j]; rd[e] = 1.f / fmaxf(fabsf(den), vec[256 + j]); sq[e] = 0.f; }
#pragma unroll
            for (int i = 0; i < 4; ++i) { const int nt = 4 * nh + i; f32x4 x = (f32x4){0.f, 0.f, 0.f, 0.f};
#pragma unroll
                for (int k = 0; k < 2; ++k) { const bf16x8 vb = *(LAS bf16x8*)(lds + VT + (16 * nt + fr) * LDB + (32 * k + 8 * fq) * 2); x = __builtin_amdgcn_mfma_f32_16x16x32_bf16(pa[k], vb, x, 0, 0, 0); }
#pragma unroll
                for (int e = 0; e < 4; ++e) { const float t = (wi[e] * inter[i][e] + x[e]) * rd[e]; hv[i][e] = t; sq[e] += t * t; } }
#pragma unroll
            for (int e = 0; e < 4; ++e) { float v = sq[e]; v += __shfl_xor(v, 1); v += __shfl_xor(v, 2); v += __shfl_xor(v, 4); v += __shfl_xor(v, 8); if (fr == 0) atomicAdd((float*)&vec[384 + 16 * mt + 4 * fq + e], v); }
        }
        {
            const float decay = vec[448];
            bf16x8 ka[2];
#pragma unroll
            for (int k = 0; k < 2; ++k) ka[k] = *(LAS bf16x8*)(lds + KWT + (16 * mt + fr) * LDB + (32 * k + 8 * fq) * 2);
#pragma unroll
            for (int i = 0; i < 4; ++i) { const int nt = 4 * nh + i; Cacc[i] = Cacc[i] * decay;
#pragma unroll
                for (int k = 0; k < 2; ++k) { const bf16x8 vb = *(LAS bf16x8*)(lds + VT + (16 * nt + fr) * LDB + (32 * k + 8 * fq) * 2); Cacc[i] = __builtin_amdgcn_mfma_f32_16x16x32_bf16(ka[k], vb, Cacc[i], 0, 0, 0); }
                u32x2 o; o.x = pk2(Cacc[i][0], Cacc[i][1]); o.y = pk2(Cacc[i][2], Cacc[i][3]); *(LAS u32x2*)(lds + CT + (16 * nt + fr) * LDB + (16 * mt + 4 * fq) * 2) = o; }
            if (tid < 64) { float a = 0.f;
#pragma unroll
                for (int q = 0; q < 8; ++q) { const bf16x8 k8 = *(LAS bf16x8*)(lds + KWT + tid * LDB + q * 16);
#pragma unroll
                    for (int e = 0; e < 8; ++e) a += bf2f((unsigned short)k8[e]); }
                LAS float* nv = (LAS float*)(lds + NV); nv[tid] = decay * nv[tid] + a; }
        }
        LBAR();
#pragma unroll
        for (int e = 0; e < 4; ++e) { const int j = 16 * mt + 4 * fq + e; const float rstd = 1.0f / sqrtf(vec[384 + j] * (1.f / 128.f) + EPS);
#pragma unroll
            for (int i = 0; i < 4; ++i) { const int v = 16 * (4 * nh + i) + fr; const float og = bf2f(MO[(row0 + j) * 512 + h * 128 + v]);
                MIX[(row0 + j) * 1024 + 512 + h * 128 + v] = (bf16)f2bf(hv[i][e] * rstd * gn[i] / (1.f + __expf(-og))); } }
    }
    MBAR();
#undef MLOAD
}
#undef MBAR
#undef LBAR
}

namespace dattn {
typedef short bf16x8 __attribute__((ext_vector_type(8)));
typedef short s16x4 __attribute__((ext_vector_type(4)));
typedef short v4i16_t __attribute__((ext_vector_type(4)));
typedef float f32x16 __attribute__((ext_vector_type(16)));
typedef unsigned u32x4 __attribute__((ext_vector_type(4)));
typedef float f32x2_t __attribute__((ext_vector_type(2))); typedef __bf16 bf16x2_t __attribute__((ext_vector_type(2)));
constexpr int SLOTB = 32768, NSLOT = 3, OFF_K2 = 8192, OFF_V = 16384, LDS_WS = NSLOT * SLOTB, LDS_X = 0, LDS_STG = 65536, LDS_END = LDS_WS + 8 * 256;
__device__ __forceinline__ int crow(int r, int hi) { return (r & 3) + 8 * (r >> 2) + 4 * hi; }
__device__ __forceinline__ void glds16(const void* gsrc, unsigned lds_dst) { unsigned keep;
    asm volatile("s_mov_b32 %0, m0\n\ts_mov_b32 m0, %2\n\ts_nop 0\n\tglobal_load_lds_dwordx4 %1, off\n\ts_mov_b32 m0, %0" : "=&s"(keep) : "v"(gsrc), "s"(lds_dst) : "memory"); }
__device__ __forceinline__ unsigned cvtpk_s(float lo, float hi) { f32x2_t v = {lo, hi}; bf16x2_t b = __builtin_convertvector(v, bf16x2_t); return __builtin_bit_cast(unsigned, b); }
__device__ __forceinline__ s16x4 vtr(LAS const unsigned char* p) { return __builtin_bit_cast(s16x4, __builtin_amdgcn_ds_read_tr16_b64_v4i16((LAS v4i16_t*)p)); }
#define DWAIT_BAR(N) asm volatile("s_waitcnt vmcnt(" #N ") lgkmcnt(0)\n\ts_barrier" ::: "memory")
__device__ __forceinline__ float rowmax(const f32x16& p0, const f32x16& p1) {
    float a = fmaxf(fmaxf(p0[0], p0[1]), p1[0]), b = fmaxf(fmaxf(p0[2], p0[3]), p1[1]); a = fmaxf(fmaxf(a, p1[2]), p1[3]);
#pragma unroll
    for (int r = 4; r < 16; r += 4) { a = fmaxf(fmaxf(a, p0[r]), p0[r + 1]); b = fmaxf(fmaxf(b, p0[r + 2]), p0[r + 3]); a = fmaxf(fmaxf(a, p1[r]), p1[r + 1]); b = fmaxf(fmaxf(b, p1[r + 2]), p1[r + 3]); }
    const float m = fmaxf(a, b);
    auto rr = __builtin_amdgcn_permlane32_swap(__float_as_uint(m), __float_as_uint(m), false, false);
    return fmaxf(__uint_as_float(rr[0]), __uint_as_float(rr[1]));
}
template <int THRL>
__device__ __forceinline__ void unit(int bh, int qb, const bf16* Q, const bf16* K, const bf16* V, bf16* MIX, float lam, const float* dnorm, LAS unsigned char* lds) {
    const int tid = threadIdx.x, lane = tid & 63, r32 = lane & 31, hi = lane >> 5; const int wid = __builtin_amdgcn_readfirstlane(tid >> 6);
    const int c = wid >> 2, qs = wid & 3, b = bh >> 2, h = bh & 3;
    const size_t rowbase = (size_t)b * SEQ; const int q0 = qb * 128 + qs * 32;
    const bf16* Kh = K + rowbase * 512 + h * 128; const bf16* Vh = V + rowbase * 512 + h * 128;
    const unsigned lds0 = (unsigned)(uintptr_t)lds;
    LAS float* wsf = (LAS float*)(lds + LDS_WS) + wid * 64;
    const bf16* ksrc = Kh + (size_t)lane * 512 + wid * 8;
    const bf16* vsrc = Vh + (size_t)(16 * (wid & 3) + (lane >> 2)) * 512 + (wid >> 2) * 32 + (lane & 3) * 8;
    const unsigned kdst = lds0 + wid * 1024, vdst = lds0 + OFF_V + wid * 1024;
#define DMA_T(t, slot) do { const size_t go_ = (size_t)(t) * 64 * 512; \
        glds16(ksrc + go_, (unsigned)__builtin_amdgcn_readfirstlane(kdst + (slot))); glds16(ksrc + go_ + 64, (unsigned)__builtin_amdgcn_readfirstlane(kdst + (slot) + OFF_K2)); \
        glds16(vsrc + go_, (unsigned)__builtin_amdgcn_readfirstlane(vdst + (slot))); glds16(vsrc + go_ + 64, (unsigned)__builtin_amdgcn_readfirstlane(vdst + (slot) + 8192)); } while (0)
    const int NT = 2 * qb + 2;
    DMA_T(0, 0); DMA_T(1, SLOTB);
    bf16x8 qr[4];
    { const bf16* Qw = Q + (rowbase + q0 + r32) * 512 + h * 128 + c * 64 + hi * 8;
#pragma unroll
      for (int d0 = 0; d0 < 4; ++d0) qr[d0] = *(const bf16x8*)(Qw + d0 * 16); }
    float gnv[4];
#pragma unroll
    for (int d0 = 0; d0 < 4; ++d0) gnv[d0] = dnorm[32 * d0 + r32] * (1.f - LAM_INIT);
    float mhat = 0.f, l_reg = 0.f; f32x16 o[4];
#pragma unroll
    for (int d0 = 0; d0 < 4; ++d0) o[d0] = f32x16{};
    f32x16 negm = f32x16{};
    const int qrel = qs * 32 + r32;
    const int vboff = OFF_V + ((lane >> 4) & 1) * 32 + (lane & 3) * 8 + (4 * hi + ((lane & 15) >> 2)) * 64;
    int slot = 0, slot_free = 2 * SLOTB;
    for (int t = 0; t < NT; ++t) {
        if (t + 1 < NT) DWAIT_BAR(4); else DWAIT_BAR(0);
        if (t + 2 < NT) DMA_T(t + 2, slot_free);
        const int jb = t - 2 * qb;
        if (!(jb == 1 && qs < 2)) {
            f32x16 p0, p1;
            { LAS const unsigned char* kb = lds + slot + c * OFF_K2 + hi * 1024 + r32 * 16;
#pragma unroll
              for (int d0 = 0; d0 < 4; ++d0) { const bf16x8 b0 = *(LAS const bf16x8*)(kb + d0 * 2048), b1 = *(LAS const bf16x8*)(kb + d0 * 2048 + 512);
                  if (d0 == 0) { p0 = __builtin_amdgcn_mfma_f32_32x32x16_bf16(b0, qr[0], negm, 0, 0, 0); p1 = __builtin_amdgcn_mfma_f32_32x32x16_bf16(b1, qr[0], negm, 0, 0, 0); }
                  else { p0 = __builtin_amdgcn_mfma_f32_32x32x16_bf16(b0, qr[d0], p0, 0, 0, 0); p1 = __builtin_amdgcn_mfma_f32_32x32x16_bf16(b1, qr[d0], p1, 0, 0, 0); } } }
            if (jb >= 0) { const int kb_ = 64 * jb + 4 * hi;
#pragma unroll
                for (int r = 0; r < 16; ++r) { const int kv = kb_ + (r & 3) + 8 * (r >> 2); if (kv > qrel) p0[r] = -INFINITY; if (kv + 32 > qrel) p1[r] = -INFINITY; } }
            const float rm = rowmax(p0, p1);
            if (t == 0 || __any(rm > (float)THRL)) {
                const float dl = (t == 0) ? rm : fmaxf(rm, 0.f); mhat += dl;
#pragma unroll
                for (int r = 0; r < 16; ++r) { p0[r] -= dl; p1[r] -= dl; negm[r] = -mhat; }
                const float f = __builtin_amdgcn_exp2f(-dl); l_reg *= f;
                if (t > 0) { if (hi == 0) wsf[r32] = f; asm volatile("s_waitcnt lgkmcnt(0)" ::: "memory");
#pragma unroll
                    for (int r = 0; r < 16; ++r) { const float fr_ = wsf[crow(r, hi)];
#pragma unroll
                        for (int d0 = 0; d0 < 4; ++d0) o[d0][r] *= fr_; }
                    asm volatile("s_waitcnt lgkmcnt(0)" ::: "memory"); }
            }
            float sacc = 0.f;
#pragma unroll
            for (int r = 0; r < 16; ++r) { p0[r] = __builtin_amdgcn_exp2f(p0[r]); p1[r] = __builtin_amdgcn_exp2f(p1[r]); sacc += p0[r] + p1[r]; }
            l_reg += sacc;
            u32x4 pw[4];
#pragma unroll
            for (int q4 = 0; q4 < 4; ++q4) { pw[0][q4] = cvtpk_s(p0[2 * q4], p0[2 * q4 + 1]); pw[1][q4] = cvtpk_s(p0[8 + 2 * q4], p0[8 + 2 * q4 + 1]); pw[2][q4] = cvtpk_s(p1[2 * q4], p1[2 * q4 + 1]); pw[3][q4] = cvtpk_s(p1[8 + 2 * q4], p1[8 + 2 * q4 + 1]); }
            LAS const unsigned char* vb = lds + slot + vboff;
#pragma unroll
            for (int d0 = 0; d0 < 4; ++d0)
#pragma unroll
                for (int ks = 0; ks < 4; ++ks) { const s16x4 lo = vtr(vb + d0 * 4096 + ks * 1024), hh = vtr(vb + d0 * 4096 + ks * 1024 + 512);
                    const bf16x8 vf = (bf16x8){lo[0], lo[1], lo[2], lo[3], hh[0], hh[1], hh[2], hh[3]};
                    o[d0] = __builtin_amdgcn_mfma_f32_32x32x16_bf16(__builtin_bit_cast(bf16x8, pw[ks]), vf, o[d0], 0, 0, 0); }
        }
        slot_free = slot_free == 2 * SLOTB ? 0 : slot_free + SLOTB; slot = slot == 2 * SLOTB ? 0 : slot + SLOTB;
    }
    { auto rr = __builtin_amdgcn_permlane32_swap(__float_as_uint(l_reg), __float_as_uint(l_reg), false, false); l_reg = __uint_as_float(rr[0]) + __uint_as_float(rr[1]); }
    if (hi == 0) wsf[32 + r32] = l_reg;
    asm volatile("s_waitcnt lgkmcnt(0)" ::: "memory");
    float rli[16];
#pragma unroll
    for (int r = 0; r < 16; ++r) rli[r] = 1.0f / wsf[32 + crow(r, hi)];
    DWAIT_BAR(0);
    LAS float* X = (LAS float*)(lds + LDS_X) + qs * 4096;
    if (c == 1) {
#pragma unroll
        for (int d0 = 0; d0 < 4; ++d0)
#pragma unroll
            for (int r = 0; r < 16; ++r) X[(d0 * 16 + r) * 64 + lane] = o[d0][r] * rli[r];
    }
    DWAIT_BAR(0);
    if (c == 0) {
        float ss[16];
#pragma unroll
        for (int r = 0; r < 16; ++r) { ss[r] = 0.f;
#pragma unroll
            for (int d0 = 0; d0 < 4; ++d0) { const float v = o[d0][r] * rli[r] - lam * X[(d0 * 16 + r) * 64 + lane]; o[d0][r] = v; ss[r] += v * v; } }
#pragma unroll
        for (int r = 0; r < 16; ++r) { float v = ss[r]; v += __shfl_xor(v, 1); v += __shfl_xor(v, 2); v += __shfl_xor(v, 4); v += __shfl_xor(v, 8); v += __shfl_xor(v, 16); ss[r] = 1.0f / sqrtf(v * (1.f / 128.f) + EPS); }
        LAS unsigned short* stg = (LAS unsigned short*)(lds + LDS_STG) + qs * 4096;
#pragma unroll
        for (int r = 0; r < 16; ++r) { const int orow = crow(r, hi);
#pragma unroll
            for (int d0 = 0; d0 < 4; ++d0) stg[orow * 128 + d0 * 32 + r32] = (unsigned short)f2bf(o[d0][r] * ss[r] * gnv[d0]); }
        asm volatile("s_waitcnt lgkmcnt(0)" ::: "memory");
        bf16* Ow = MIX + (rowbase + q0) * 1024 + h * 128;
#pragma unroll
        for (int i = 0; i < 8; ++i) { const int id = i * 64 + lane, row = id >> 4, ch = id & 15; const u32x4 v = *(LAS const u32x4*)((LAS const unsigned char*)stg + row * 256 + ch * 16); *(u32x4*)(Ow + (size_t)row * 1024 + ch * 8) = v; }
    }
    DWAIT_BAR(0);
#undef DMA_T
}
#undef DWAIT_BAR
}

__device__ __forceinline__ void p0_transpose_item(const float* W, int K, int N, int ldW, const float* g, bf16* WT, LAS float* scr, int item, int lane) {
    const int nblk = N / 32, kb = item / nblk, nb = item % nblk, k0 = 64 * kb, n0 = 32 * nb;
#pragma unroll 8
    for (int i = 0; i < 32; ++i) { const int kk = 2 * i + (lane >> 5); scr[kk * 33 + (lane & 31)] = W[(size_t)(k0 + kk) * ldW + n0 + (lane & 31)] * (g ? g[k0 + kk] : 1.f); }
    LDS_WAIT(); asm volatile("" ::: "memory");
    const int c = lane & 7;
#pragma unroll
    for (int j = 0; j < 4; ++j) { const int n = (lane >> 3) + 8 * j; const LAS float* s = scr + (8 * c) * 33 + n;
        v4u o; o.x = pk2(s[0 * 33], s[1 * 33]); o.y = pk2(s[2 * 33], s[3 * 33]); o.z = pk2(s[4 * 33], s[5 * 33]); o.w = pk2(s[6 * 33], s[7 * 33]);
        *(GAS v4u*)(WT + (size_t)(n0 + n) * K + k0 + 8 * c) = o; }
    LDS_WAIT(); asm volatile("" ::: "memory");
}
__device__ __forceinline__ void p0_row(const float* x, const float* WG, const float* b_i, const float* b_f, bf16* XN, float* GATES, int row, int lane) {
    const GAS f32x4* xr = (const GAS f32x4*)(x + (size_t)row * DM) + lane;
    f32x4 v[4]; float ss = 0.f;
#pragma unroll
    for (int j = 0; j < 4; ++j) { v[j] = xr[64 * j]; ss += (v[j].x * v[j].x + v[j].y * v[j].y) + (v[j].z * v[j].z + v[j].w * v[j].w); }
    const float rstd = 1.0f / sqrtf(wave_sum(ss) * (1.f / DM) + EPS);
    GAS unsigned long long* o8 = (GAS unsigned long long*)(XN + (size_t)row * DM) + lane;
#pragma unroll
    for (int j = 0; j < 4; ++j) o8[64 * j] = (unsigned long long)pk2(v[j].x * rstd, v[j].y * rstd) | ((unsigned long long)pk2(v[j].z * rstd, v[j].w * rstd) << 32);
    float mine = 0.f;
#pragma unroll
    for (int q = 0; q < 8; ++q) {
        const GAS f32x4* wr = (const GAS f32x4*)(WG + q * 1024) + lane; float a = 0.f;
#pragma unroll
        for (int j = 0; j < 4; ++j) { const f32x4 w = wr[64 * j]; a += (v[j].x * w.x + v[j].y * w.y) + (v[j].z * w.z + v[j].w * w.w); }
        a = wave_sum(a) * rstd; if (lane == q) mine = a;
    }
    if (lane < 4) GATES[(size_t)row * 8 + lane] = mine + b_i[lane];
    else if (lane < 8) { const float z = mine + b_f[lane - 4]; GATES[(size_t)row * 8 + lane] = fminf(z, 0.f) - log1pf(expf(-fabsf(z))); }
}
__device__ __forceinline__ void rownorm1(const float* x, const float* T1, const float* gpost, float* X1, bf16* X1N, int row, int lane) {
    const GAS f32x4* tr = (const GAS f32x4*)(T1 + (size_t)row * DM) + lane; const GAS f32x4* xr = (const GAS f32x4*)(x + (size_t)row * DM) + lane; const GAS f32x4* gr = (const GAS f32x4*)gpost + lane;
    f32x4 t[4]; float ss = 0.f;
#pragma unroll
    for (int j = 0; j < 4; ++j) { t[j] = tr[64 * j]; ss += (t[j].x * t[j].x + t[j].y * t[j].y) + (t[j].z * t[j].z + t[j].w * t[j].w); }
    const float rstd = 1.0f / sqrtf(wave_sum(ss) * (1.f / DM) + EPS); float s2 = 0.f;
#pragma unroll
    for (int j = 0; j < 4; ++j) { t[j] = xr[64 * j] + t[j] * rstd * gr[64 * j]; s2 += (t[j].x * t[j].x + t[j].y * t[j].y) + (t[j].z * t[j].z + t[j].w * t[j].w); }
    const float rstd2 = 1.0f / sqrtf(wave_sum(s2) * (1.f / DM) + EPS);
    GAS f32x4* o = (GAS f32x4*)(X1 + (size_t)row * DM) + lane; GAS unsigned long long* o8 = (GAS unsigned long long*)(X1N + (size_t)row * DM) + lane;
#pragma unroll
    for (int j = 0; j < 4; ++j) { o[64 * j] = t[j]; o8[64 * j] = (unsigned long long)pk2(t[j].x * rstd2, t[j].y * rstd2) | ((unsigned long long)pk2(t[j].z * rstd2, t[j].w * rstd2) << 32); }
}
__device__ __forceinline__ void rownorm2(const float* T2, const float* g, float* out, int row, int lane) {
    const GAS f32x4* tr = (const GAS f32x4*)(T2 + (size_t)row * DM) + lane; const GAS f32x4* gr = (const GAS f32x4*)g + lane; GAS f32x4* o = (GAS f32x4*)(out + (size_t)row * DM) + lane;
    f32x4 t[4]; float ss = 0.f;
#pragma unroll
    for (int j = 0; j < 4; ++j) { t[j] = tr[64 * j]; ss += (t[j].x * t[j].x + t[j].y * t[j].y) + (t[j].z * t[j].z + t[j].w * t[j].w); }
    const float rstd = 1.0f / sqrtf(wave_sum(ss) * (1.f / DM) + EPS);
#pragma unroll
    for (int j = 0; j < 4; ++j) o[64 * j] = o[64 * j] + t[j] * rstd * gr[64 * j];
}

struct Args { const float* in[19]; float* out; unsigned char* ws; int ph_lo, ph_hi, use_cg, pad; };
constexpr int N_PHASES = 8;

__global__ void __launch_bounds__(NWAVES * 64, 2) mk_fwd(Args args) {
    extern __shared__ __attribute__((aligned(16))) unsigned char lds_raw[];
    LAS unsigned char* lds = (LAS unsigned char*)lds_raw;
    volatile LAS unsigned* MISC = (volatile LAS unsigned*)(lds + MISC_OFF);
    const int tid = threadIdx.x, lane = tid & 63, wave = __builtin_amdgcn_readfirstlane(tid >> 6);
    const int G = gridDim.x; const int bx = blockIdx.x; const int vcu = (G % 8 == 0) ? (bx % 8) * (G / 8) + bx / 8 : bx;
    unsigned char* ws = args.ws;
    gu32* ctl = (gu32*)(ws + WS_CTL);
    const float* x = args.in[0]; float* out = args.out;
    bf16 *W1 = (bf16*)(ws + WS_W1), *W2 = (bf16*)(ws + WS_W2), *W3 = (bf16*)(ws + WS_W3), *W4 = (bf16*)(ws + WS_W4), *XN = (bf16*)(ws + WS_XN);
    bf16 *Qb = (bf16*)(ws + WS_Q), *Kb = (bf16*)(ws + WS_K), *Vb = (bf16*)(ws + WS_V), *MQ = (bf16*)(ws + WS_MQ), *MK = (bf16*)(ws + WS_MK), *MV = (bf16*)(ws + WS_MV), *MO = (bf16*)(ws + WS_MO);
    bf16 *MIX = (bf16*)(ws + WS_MIX), *X1N = (bf16*)(ws + WS_X1N), *U = (bf16*)(ws + WS_U);
    float *WG = (float*)(ws + WS_WG), *GATES = (float*)(ws + WS_GATES), *T1 = (float*)(ws + WS_T1), *T2 = (float*)(ws + WS_T2), *ROPE = (float*)(ws + WS_ROPE);
    for (int u = tid; u < (LDS_BYTES - LDSCTL_OFF) / 4; u += NWAVES * 64) ((LAS unsigned*)(lds + LDSCTL_OFF))[u] = 0u;
    __syncthreads();
    XcdBarrier bar; bar.bar = (unsigned*)(ctl + CW_BAR); bar.x = 0; bar.st = nullptr;
    if (!args.use_cg) bar = xcd_barrier_post((unsigned*)(ctl + CW_BAR), MISC + 8);
#define GRID_BAR() do { if (args.use_cg) cg::this_grid().sync(); else xcd_barrier(bar); } while (0)
    const int lo = args.ph_lo, hi = args.ph_hi;
#define IN(k) (lo <= (k) && (k) < hi)
#define BOTH(k) (IN(k) && IN((k) + 1))
    const int gw = vcu * NWAVES + wave, NGW = G * NWAVES;

    if (IN(0)) {
        LAS float* scr = (LAS float*)(lds + RING_OFF + wave * 16384);
        constexpr int I1 = (DM / 64) * (NPROJ / 32), I2 = (DM / 64) * (DM / 32), I3 = (DM / 64) * (FF / 32), I4 = (FF / 64) * (DM / 32);
        for (int it = gw; it < I1 + I2 + I3 + I4; it += NGW) {
            int r = it;
            if (r < I1) { p0_transpose_item(args.in[2], DM, NPROJ, INW, args.in[1], W1, scr, r, lane); continue; } r -= I1;
            if (r < I2) { p0_transpose_item(args.in[13], DM, DM, DM, nullptr, W2, scr, r, lane); continue; } r -= I2;
            if (r < I3) { p0_transpose_item(args.in[16], DM, FF, FF, args.in[15], W3, scr, r, lane); continue; } r -= I3;
            p0_transpose_item(args.in[17], FF, DM, DM, nullptr, W4, scr, r, lane);
        }
        {
            const int i = bx * (NWAVES * 64) + tid;
            if (i < 8 * 1024) { const int j = i >> 10, k = i & 1023; WG[i] = args.in[1][k] * args.in[2][(size_t)k * INW + NPROJ + j]; }
            if (i < SEQ * 32) { const int pos = i >> 5, j = i & 31; const float inv = (float)pow(10000.0, -(double)(2 * j) / 64.0); const float ang = (float)pos * inv;
                ROPE[2 * i] = (float)cos((double)ang); ROPE[2 * i + 1] = (float)sin((double)ang); }
        }
        GRID_BAR();
        for (int m = gw; m < M; m += NGW) p0_row(x, WG, args.in[5], args.in[6], XN, GATES, m, lane);
        if (BOTH(0)) GRID_BAR();
    }
    if (IN(1)) {
        pg8::Gemm g{XN, W1, M, NPROJ, DM}; pg8::StaticOrder S; S.init(M, NPROJ, G, bx);
        pg8::EpiProj E{Qb, Kb, Vb, MQ, MK, MV, MO, ROPE};
        pg8::gemm_phase<pg8::EpiProj, pg8::StaticOrder, true, true>(lds + RING_OFF, g, S, E);
        if (BOTH(1)) GRID_BAR();
    }
    if (IN(2)) {
        if (bx < 128) mlstm::chain(bx, MQ, MK, MV, MO, GATES, args.in[3], args.in[4], args.in[12], MIX, lds);
        const float lam = expf(wave_sum(args.in[7][lane] * args.in[8][lane])) - expf(wave_sum(args.in[9][lane] * args.in[10][lane])) + LAM_INIT;
        for (int k = 0; k < 8; ++k) {
            const int q = (bx + k) & 7;
            for (;;) {
                if (tid == 0) MISC[0] = __hip_atomic_fetch_add(ctl + CW_QUEUE + 64 * q, 1u, RLX_AGENT);
                __syncthreads();
                const unsigned idx = MISC[0];
                __syncthreads();
                if (idx >= 256u) break;
                dattn::unit<8>(q + 8 * (int)(idx >> 4), 15 - (int)(idx & 15u), Qb, Kb, Vb, MIX, lam, args.in[11], lds);
            }
        }
        if (BOTH(2)) GRID_BAR();
    }
    if (IN(3)) {
        pg8::Gemm g{MIX, W2, M, DM, DM}; pg8::StaticOrder S; S.init(M, DM, G, bx);
        pg8::EpiF32 E{T1, DM};
        pg8::gemm_phase<pg8::EpiF32, pg8::StaticOrder, true, true>(lds + RING_OFF, g, S, E);
        if (BOTH(3)) GRID_BAR();
    }
    if (IN(4)) {
        for (int m = gw; m < M; m += NGW) rownorm1(x, T1, args.in[14], out, X1N, m, lane);
        if (BOTH(4)) GRID_BAR();
    }
    if (IN(5)) {
        pg8::Gemm g{X1N, W3, M, FF, DM}; pg8::StaticOrder S; S.init(M, FF, G, bx);
        pg8::EpiRelu2 E{U, FF};
        pg8::gemm_phase<pg8::EpiRelu2, pg8::StaticOrder, true, true>(lds + RING_OFF, g, S, E);
        if (BOTH(5)) GRID_BAR();
    }
    if (IN(6)) {
        pg8::Gemm g{U, W4, M, DM, FF}; pg8::StaticOrder S; S.init(M, DM, G, bx);
        pg8::EpiF32 E{T2, DM};
        pg8::gemm_phase<pg8::EpiF32, pg8::StaticOrder, true, true>(lds + RING_OFF, g, S, E);
        if (BOTH(6)) GRID_BAR();
    }
    if (IN(7)) { for (int m = gw; m < M; m += NGW) rownorm2(T2, args.in[18], out, m, lane); }
#undef IN
#undef BOTH
}

extern "C" void kernel_launch(void* const* d_in, const int* in_sizes, int n_in, void* d_out, int out_size, void* d_ws, size_t ws_size, hipStream_t stream) {
    static int grid = 0;
    if (grid == 0) {
        if (n_in != 19 || in_sizes[0] != M * DM || out_size != M * DM || ws_size < WS_END) { fprintf(stderr, "kernel_launch: unexpected problem shape (n_in %d, ws %zu)\n", n_in, ws_size); grid = -1; return; }
        int dev = 0, cus = 0, per_cu = 0;
        if (hipGetDevice(&dev) != hipSuccess || hipDeviceGetAttribute(&cus, hipDeviceAttributeMultiprocessorCount, dev) != hipSuccess) { grid = -1; return; }
        if (hipFuncSetAttribute((const void*)mk_fwd, hipFuncAttributeMaxDynamicSharedMemorySize, LDS_BYTES) != hipSuccess) { fprintf(stderr, "kernel_launch: hipFuncSetAttribute failed\n"); grid = -1; return; }
        if (hipOccupancyMaxActiveBlocksPerMultiprocessor(&per_cu, (const void*)mk_fwd, NWAVES * 64, LDS_BYTES) != hipSuccess || per_cu < 1) { fprintf(stderr, "kernel_launch: occupancy query says %d\n", per_cu); per_cu = 1; }
        (void)hipGetLastError();
        grid = cus;
    }
    if (grid < 0) return;
    (void)hipMemsetAsync((char*)d_ws + WS_CTL, 0, CTL_ZERO_BYTES, stream);
    unsigned char* ws = (unsigned char*)d_ws; float* out = (float*)d_out;
    Args a{};
    for (int i = 0; i < 19; ++i) a.in[i] = (const float*)d_in[i];
    a.out = out; a.ws = ws; a.use_cg = 0;
    auto launch = [&](int lo, int hi) {
        a.ph_lo = lo; a.ph_hi = hi; void* kargs[] = {&a};
        hipError_t e = hipLaunchCooperativeKernel((const void*)mk_fwd, dim3(grid), dim3(NWAVES * 64), kargs, LDS_BYTES, stream);
        if (e != hipSuccess) fprintf(stderr, "kernel_launch: cooperative launch failed: %s (grid %d)\n", hipGetErrorString(e), grid);
    };
    launch(0, 8);
}
```
